# Optimizing an MI355X kernel written in HIP

```python
import jax, jax.numpy as jnp
from jax import lax
import numpy as np

D_MODEL = 1024
BATCH = 1
SEQ = 16384
DEPTH = 2

CHUNK = 64
N_MEM = 256
ROPE_THETA = 10000.0
LN_EPS = 1e-5

POOL_GROUPS = 4
POOL_GROUP_DIM = 128
POOL_WINDOWS = (2, 4, 8, 16)
POOL_WIDTH = POOL_GROUPS * POOL_GROUP_DIM
ATT_HEADS = 8
ATT_HEAD_DIM = 64
ATT_WIDTH = ATT_HEADS * ATT_HEAD_DIM
IDX_HEADS = 8
IDX_HEAD_DIM = 64
TOPK_MAX = 256
Q_BLOCK = 128
MEM_HEADS = 4
MEM_HEAD_DIM = 128
MEM_WIDTH = MEM_HEADS * MEM_HEAD_DIM
N_BRANCH = 3
BRANCH_WIDTH = 512
IN_WIDTHS = (POOL_WIDTH, ATT_WIDTH, ATT_WIDTH, ATT_WIDTH, IDX_HEADS * IDX_HEAD_DIM,
             IDX_HEAD_DIM, IDX_HEADS, MEM_WIDTH, N_BRANCH * D_MODEL)
D_IN = sum(IN_WIDTHS)
N_EXPERTS = 16
N_GROUPS = 4
EXPERTS_PER_GROUP = N_EXPERTS // N_GROUPS
TOP_K_EXPERTS = 2
GROUP_SCORE_TOPK = 2
D_EXPERT = 512
MOE_BLOCK = 128
DN_ALPHA = (2 * DEPTH) ** 0.25
DN_BETA = (8 * DEPTH) ** -0.25

kernel_name = 'hybrid_pool_dsa_mem_moe_deepnorm'


def layer_norm(x, g, b):
    xf = x.astype(jnp.float32)
    mu = jnp.mean(xf, axis=-1, keepdims=True)
    var = jnp.mean(jnp.square(xf - mu), axis=-1, keepdims=True)
    y = (xf - mu) * lax.rsqrt(var + LN_EPS) * g.astype(jnp.float32) + b.astype(jnp.float32)
    return y.astype(x.dtype)


def rotary(x, positions):
    half = x.shape[-1] // 2
    inv_freq = ROPE_THETA ** (-jnp.arange(half, dtype=jnp.float32) / half)
    ang = positions.astype(jnp.float32)[..., None] * inv_freq
    cos = jnp.cos(ang)[:, :, None, :]
    sin = jnp.sin(ang)[:, :, None, :]
    xf = x.astype(jnp.float32)
    x1, x2 = xf[..., :half], xf[..., half:]
    out = jnp.concatenate([x1 * cos - x2 * sin, x2 * cos + x1 * sin], axis=-1)
    return out.astype(x.dtype)


def pool_branch(u, pool_w, pool_scale):
    B, S, _ = u.shape
    u = u.reshape(B, S, POOL_GROUPS, POOL_GROUP_DIM)
    t = jnp.arange(S)
    outs = []
    for g, w in enumerate(POOL_WINDOWS):
        ug = u[:, :, g].astype(jnp.float32)
        cs = jnp.cumsum(ug, axis=1)
        lagged = jnp.pad(cs, ((0, 0), (w, 0), (0, 0)))[:, :S]
        cnt = jnp.minimum(t + 1, w).astype(jnp.float32)[None, :, None]
        outs.append((cs - lagged) / cnt - ug)
    d = jnp.stack(outs, axis=2).astype(u.dtype)
    mixed = jnp.einsum('bsgc,gce->bsge', d, pool_w).reshape(B, S, POOL_WIDTH)
    return mixed * pool_scale


def dsa_branch(q, k, v, iq, ik, iw, positions):
    B, S, _ = q.shape
    q = rotary(q.reshape(B, S, ATT_HEADS, ATT_HEAD_DIM), positions)
    k = rotary(k.reshape(B, S, ATT_HEADS, ATT_HEAD_DIM), positions)
    v = v.reshape(B, S, ATT_HEADS, ATT_HEAD_DIM)
    iq = rotary(iq.reshape(B, S, IDX_HEADS, IDX_HEAD_DIM), positions)
    ik = rotary(ik[:, :, None, :], positions)[:, :, 0]
    iw = iw * (IDX_HEADS ** -0.5)
    n_sel = min(TOPK_MAX, S // 4)
    nb = S // Q_BLOCK
    key_chunk = jnp.arange(S) // CHUNK

    def to_blocks(a):
        return a.reshape(B, nb, Q_BLOCK, *a.shape[2:]).swapaxes(0, 1)

    def attend_block(args):
        blk, qb, iqb, iwb = args
        t = blk * Q_BLOCK + jnp.arange(Q_BLOCK)
        q_chunk = t // CHUNK
        admissible = key_chunk[None, :] <= q_chunk[:, None]
        rel = jax.nn.relu(jnp.einsum('bqhd,bsd->bqhs', iqb, ik) * (IDX_HEAD_DIM ** -0.5))
        score = jnp.einsum('bqhs,bqh->bqs', rel, iwb).astype(jnp.float32)
        score = jnp.where(admissible[None], score, -jnp.inf)
        _, sel = lax.top_k(score, n_sel)
        valid = (sel // CHUNK) <= q_chunk[None, :, None]
        kg = jax.vmap(lambda kk, ii: kk[ii])(k, sel)
        vg = jax.vmap(lambda vv, ii: vv[ii])(v, sel)
        s = jnp.einsum('bqhd,bqkhd->bqhk', qb, kg).astype(jnp.float32) * (ATT_HEAD_DIM ** -0.5)
        s = jnp.where(valid[:, :, None, :], s, -jnp.inf)
        p = jax.nn.softmax(s, axis=-1).astype(vg.dtype)
        return jnp.einsum('bqhk,bqkhd->bqhd', p, vg)

    out = lax.map(attend_block, (jnp.arange(nb), to_blocks(q), to_blocks(iq), to_blocks(iw)))
    return out.swapaxes(0, 1).reshape(B, S, ATT_WIDTH)


def memory_branch(mq, mem, w_mem_kv):
    B, S, _ = mq.shape
    M = mem.shape[1]
    kv = jnp.einsum('bmd,de->bme', mem, w_mem_kv)
    mk, mv = jnp.split(kv, 2, axis=-1)
    mk = mk.reshape(B, M, MEM_HEADS, MEM_HEAD_DIM)
    mv = mv.reshape(B, M, MEM_HEADS, MEM_HEAD_DIM)
    q = mq.reshape(B, S, MEM_HEADS, MEM_HEAD_DIM)
    s = jnp.einsum('bshd,bmhd->bhsm', q, mk).astype(jnp.float32) * (MEM_HEAD_DIM ** -0.5)
    p = jax.nn.softmax(s, axis=-1).astype(mv.dtype)
    return jnp.einsum('bhsm,bmhd->bshd', p, mv).reshape(B, S, MEM_WIDTH)


def token_mixing(x, mem, positions, w_in, b_in, pool_w, pool_scale, w_mem_kv, w_br, w_out):
    B, S, D = x.shape
    proj = jnp.einsum('bsd,de->bse', x, w_in) + b_in
    split_points = np.cumsum(IN_WIDTHS)[:-1].tolist()
    u_pool, q, k, v, iq, ik, iw, mq, gate_logits = jnp.split(proj, split_points, axis=-1)
    gates = jax.nn.sigmoid(gate_logits.astype(jnp.float32)).astype(x.dtype).reshape(B, S, N_BRANCH, D)
    branches = (pool_branch(u_pool, pool_w, pool_scale),
                dsa_branch(q, k, v, iq, ik, iw, positions),
                memory_branch(mq, mem, w_mem_kv))
    merged = jnp.zeros_like(x)
    for n in range(N_BRANCH):
        merged = merged + gates[:, :, n] * jnp.einsum('bsc,cd->bsd', branches[n], w_br[n])
    return jnp.einsum('bsd,de->bse', merged, w_out)


def route(x2, w_router, router_bias):
    scores = jax.nn.sigmoid(jnp.einsum('nd,de->ne', x2, w_router).astype(jnp.float32))
    biased = scores + router_bias.astype(jnp.float32)
    grouped = biased.reshape(-1, N_GROUPS, EXPERTS_PER_GROUP)
    group_score = lax.top_k(grouped, GROUP_SCORE_TOPK)[0].sum(-1)
    best = jnp.argmax(group_score, axis=-1).astype(jnp.int32)
    within = jnp.take_along_axis(grouped, best[:, None, None], axis=1)[:, 0]
    _, local = lax.top_k(within, TOP_K_EXPERTS)
    expert_idx = (best[:, None] * EXPERTS_PER_GROUP + local).astype(jnp.int32)
    w = jnp.take_along_axis(scores, expert_idx, axis=1)
    w = w / jnp.sum(w, axis=-1, keepdims=True)
    return expert_idx, w


def moe(x2, w_router, router_bias, w1, w3, w2):
    N, D = x2.shape
    expert_idx, gate_w = route(x2, w_router, router_bias)
    n_assign = N * TOP_K_EXPERTS
    n_blk = -(-n_assign // MOE_BLOCK) + N_EXPERTS
    flat_e = expert_idx.reshape(-1)
    flat_tok = jnp.repeat(jnp.arange(N, dtype=jnp.int32), TOP_K_EXPERTS)
    flat_g = gate_w.reshape(-1).astype(x2.dtype)
    order = jnp.argsort(flat_e)
    e_sorted = flat_e[order]
    counts = jax.ops.segment_sum(jnp.ones_like(flat_e), flat_e, num_segments=N_EXPERTS)
    padded = ((counts + MOE_BLOCK - 1) // MOE_BLOCK) * MOE_BLOCK
    pad_end = jnp.cumsum(padded)
    pad_start = pad_end - padded
    start = jnp.cumsum(counts) - counts
    rank = jnp.arange(n_assign, dtype=jnp.int32) - start[e_sorted]
    dest = pad_start[e_sorted] + rank
    slot_tok = jnp.full((n_blk * MOE_BLOCK,), N, jnp.int32).at[dest].set(flat_tok[order])
    slot_gate = jnp.zeros((n_blk * MOE_BLOCK,), x2.dtype).at[dest].set(flat_g[order])
    blk_e = jnp.minimum(jnp.searchsorted(pad_end, jnp.arange(n_blk) * MOE_BLOCK, side='right'),
                        N_EXPERTS - 1).astype(jnp.int32)
    x_pad = jnp.concatenate([x2, jnp.zeros((1, D), x2.dtype)], axis=0)

    def run_block(args):
        e, toks = args
        xb = x_pad[toks]
        h = jax.nn.silu(xb @ w1[e]) * (xb @ w3[e])
        return h @ w2[e]

    yb = lax.map(run_block, (blk_e, slot_tok.reshape(n_blk, MOE_BLOCK)))
    y = yb.reshape(-1, D) * slot_gate[:, None]
    return jnp.zeros((N + 1, D), x2.dtype).at[slot_tok].add(y)[:N]


def setup_inputs(seed: int = 0) -> dict:
    key = jax.random.key(seed)
    ks = jax.random.split(key, 20)
    f32 = jnp.float32
    nrm = lambda k, shape, scale: jax.random.normal(k, shape, f32) * scale
    return {
        'x': nrm(ks[0], (BATCH, SEQ, D_MODEL), 1.0),
        'mem': nrm(ks[1], (BATCH, N_MEM, D_MODEL), 1.0),
        'positions': jnp.broadcast_to(jnp.arange(SEQ, dtype=jnp.int32)[None], (BATCH, SEQ)),
        'w_in': nrm(ks[2], (DEPTH, D_MODEL, D_IN), D_MODEL ** -0.5),
        'b_in': nrm(ks[3], (DEPTH, D_IN), 0.02),
        'pool_w': nrm(ks[4], (DEPTH, POOL_GROUPS, POOL_GROUP_DIM, POOL_GROUP_DIM), POOL_GROUP_DIM ** -0.5),
        'pool_scale': 1.0 + nrm(ks[5], (DEPTH, POOL_WIDTH), 0.02),
        'w_mem_kv': nrm(ks[6], (DEPTH, D_MODEL, 2 * MEM_WIDTH), D_MODEL ** -0.5),
        'w_br': nrm(ks[7], (DEPTH, N_BRANCH, BRANCH_WIDTH, D_MODEL), DN_BETA * BRANCH_WIDTH ** -0.5),
        'w_out': nrm(ks[8], (DEPTH, D_MODEL, D_MODEL), DN_BETA * D_MODEL ** -0.5),
        'ln1_g': 1.0 + nrm(ks[9], (DEPTH, D_MODEL), 0.02),
        'ln1_b': nrm(ks[10], (DEPTH, D_MODEL), 0.02),
        'w_router': nrm(ks[11], (D_MODEL, N_EXPERTS), D_MODEL ** -0.5),
        'router_bias': nrm(ks[12], (N_EXPERTS,), 0.01),
        'w1': nrm(ks[13], (DEPTH, N_EXPERTS, D_MODEL, D_EXPERT), D_MODEL ** -0.5),
        'w3': nrm(ks[14], (DEPTH, N_EXPERTS, D_MODEL, D_EXPERT), D_MODEL ** -0.5),
        'w2': nrm(ks[15], (DEPTH, N_EXPERTS, D_EXPERT, D_MODEL), DN_BETA * D_EXPERT ** -0.5),
        'ln2_g': 1.0 + nrm(ks[16], (DEPTH, D_MODEL), 0.02),
        'ln2_b': nrm(ks[17], (DEPTH, D_MODEL), 0.02),
    }


def reference(x, mem, positions, w_in, b_in, pool_w, pool_scale, w_mem_kv, w_br, w_out,
              ln1_g, ln1_b, w_router, router_bias, w1, w3, w2, ln2_g, ln2_b):
    B, S, D = x.shape
    for l in range(DEPTH):
        mix = token_mixing(x, mem, positions, w_in[l], b_in[l], pool_w[l], pool_scale[l],
                           w_mem_kv[l], w_br[l], w_out[l])
        x = layer_norm(DN_ALPHA * x + mix, ln1_g[l], ln1_b[l])
        ffn = moe(x.reshape(B * S, D), w_router, router_bias, w1[l], w3[l], w2[l]).reshape(B, S, D)
        x = layer_norm(DN_ALPHA * x + ffn, ln2_g[l], ln2_b[l])
    return x
```

```cpp
#include <hip/hip_runtime.h>
#include <hip/hip_bf16.h>
#include <cstdio>
#include <cstdint>
#include <cmath>

namespace gm {
#define GM_LAS __attribute__((address_space(3)))
typedef unsigned short bf16_t;
typedef short bf16x8 __attribute__((ext_vector_type(8)));
typedef float f32x4 __attribute__((ext_vector_type(4)));
typedef float f32x2 __attribute__((ext_vector_type(2)));
typedef unsigned u32x4 __attribute__((ext_vector_type(4)));
typedef unsigned u32x2 __attribute__((ext_vector_type(2)));
constexpr int BM = 256, BK = 64, HALF = 128, HTB = HALF * BK * 2  , STAGE_BYTES = 8 * HTB, NXCD = 8, WGM = 8;

__host__ __device__ __forceinline__ int lds_byte(int r, int c) { const int st = (r >> 4) * 2 + (c >> 5), rr = r & 15, cc = c & 31, ob = rr * 64 + cc * 2; return st * 1024 + (ob ^ (((ob >> 9) & 1) << 5)); }
__host__ __device__ __forceinline__ void stage_rc(int b, int& R, int& C) { const int st = b / 1024, sb = b % 1024, swz = sb ^ (((sb >> 9) & 1) << 5); R = (st >> 1) * 16 + swz / 64; C = (st & 1) * 32 + (swz % 64) / 2; }
__host__ __device__ __forceinline__ int perm32(int rho) { const int n = rho >> 4, i = rho & 15; return 8 * (i >> 2) + 4 * n + (i & 3); }

struct UnitX { int pm, pn, e, blk, nvalid; const char* A0; const char* A1; const char* A2; const char* B; const int* rows; };

__device__ __forceinline__ bool static_unit(long L, int nM, int nN, int& pm, int& pn) {
    const int nwg = nM * nN; if (L >= nwg) return false;
    int wgid = (int)L; { const int q = nwg / NXCD, r = nwg % NXCD, xcd = wgid % NXCD, off = wgid / NXCD; wgid = (xcd < r ? xcd * (q + 1) : r * (q + 1) + (xcd - r) * q) + off; }
    const int nig = WGM * nN, gid = wgid / nig, fm = gid * WGM, gsz = (nM - fm) < WGM ? (nM - fm) : WGM;
    pm = fm + ((wgid % nig) % gsz); pn = (wgid % nig) / gsz; return true;
}
__device__ __forceinline__ unsigned cvt_pk_bf16(float lo, float hi) { unsigned r; asm volatile("v_cvt_pk_bf16_f32 %0, %1, %2" : "=v"(r) : "v"(lo), "v"(hi)); return r; }
__device__ __forceinline__ float bf_lo(unsigned w) { return __uint_as_float(w << 16); }
__device__ __forceinline__ float bf_hi(unsigned w) { return __uint_as_float(w & 0xffff0000u); }

__device__ __forceinline__ int gm_lane_id() { int l; asm volatile("v_mbcnt_lo_u32_b32 %0, -1, 0\n\tv_mbcnt_hi_u32_b32 %0, -1, %0" : "=v"(l)); return l; }
template <class Prob, class Epi>
__device__ __forceinline__ void gemm_phase(GM_LAS unsigned char* lds, const Prob& P, const Epi& E, int wave_id) {
    int tid_ = (wave_id << 6) | gm_lane_id(); asm volatile("" : "+v"(tid_));
    const int tid = tid_, wid = __builtin_amdgcn_readfirstlane(tid >> 6), lane = tid & 63, wr = wid >> 2, wc = wid & 3, fr = lane & 15, fq = lane >> 4;
    const int K = P.K, nt = K / BK, lda = P.lda;
    unsigned voffB[2];
#pragma unroll
    for (int i = 0; i < 2; ++i) { int R, C; stage_rc(tid * 16 + i * 8192, R, C); const int Rb = Epi::PERM ? ((R & ~31) + perm32(R & 31)) : R; voffB[i] = (unsigned)(Rb * K + C) * 2u; }
    const size_t kstep = (size_t)(BK * 2);
    const size_t hstepB = (size_t)HALF * K * 2;
    const size_t hstepA = Prob::GATHER ? (size_t)0 : (size_t)HALF * lda * 2;
    const unsigned ldsw = (unsigned)wid * 1024u;
    const int aoff = lds_byte(wr * 64 + fr, fq * 8), boff = lds_byte(wc * 32 + fr, fq * 8);
#define GM_SA(b, h) (((b) * 2 + (h)) * HTB)
#define GM_SB(b, h) ((4 + (b) * 2 + (h)) * HTB)
#define GM_STAGE(bufoff, gbase, voff) do { _Pragma("unroll") for (int _i = 0; _i < 2; ++_i) \
        __builtin_amdgcn_global_load_lds((const unsigned*)((const char*)(gbase) + (voff)[_i]), (GM_LAS unsigned*)(lds + (bufoff) + ldsw + _i * 8192), 16, 0, 0); } while (0)
#define GM_LDA(dst, b, h) do { _Pragma("unroll") for (int m = 0; m < 4; ++m) _Pragma("unroll") for (int k = 0; k < 2; ++k) dst[m][k] = *(const GM_LAS bf16x8*)(lds + GM_SA(b, h) + aoff + m * 2048 + k * 1024); } while (0)
#define GM_LDB(dst, b, h) do { _Pragma("unroll") for (int n = 0; n < 2; ++n) _Pragma("unroll") for (int k = 0; k < 2; ++k) dst[n][k] = *(const GM_LAS bf16x8*)(lds + GM_SB(b, h) + boff + n * 2048 + k * 1024); } while (0)
#define GM_MMA(ai, bj, At, Bt) do { __builtin_amdgcn_s_setprio(1); _Pragma("unroll") for (int m = 0; m < 4; ++m) _Pragma("unroll") for (int n = 0; n < 2; ++n) _Pragma("unroll") for (int k = 0; k < 2; ++k) \
        acc[ai][bj][m][n] = __builtin_amdgcn_mfma_f32_16x16x32_bf16(Bt[n][k], At[m][k], acc[ai][bj][m][n], 0, 0, 0); __builtin_amdgcn_s_setprio(0); } while (0)
#define GM_WAIT_V(n) asm volatile("s_waitcnt vmcnt(" #n ")" ::: "memory")
#define GM_WAIT_L(n) asm volatile("s_waitcnt lgkmcnt(" #n ")" ::: "memory")
#define GM_BAR __builtin_amdgcn_s_barrier()
#define GM_SCHED __builtin_amdgcn_sched_barrier(0)
#define GM_APTR(u, t) ((Prob::NSEG == 3) ? ((((t) >> 3) == 0 ? (u).A0 : (((t) >> 3) == 1 ? (u).A1 : (u).A2)) + (size_t)((t) & 7) * kstep) : ((u).A0 + (size_t)(t) * kstep))
#define GM_VOFF(u, v) do { int _t = tid; asm volatile("" : "+v"(_t)); _Pragma("unroll") for (int _i = 0; _i < 2; ++_i) { int _R, _C; stage_rc(_t * 16 + _i * 8192, _R, _C); \
        _Pragma("unroll") for (int _h = 0; _h < 2; ++_h) { const int _ix = _h * HALF + _R; \
            const unsigned _r = Prob::GATHER ? ((_ix < (u).nvalid) ? ((unsigned)((const __attribute__((address_space(1))) int*)(u).rows)[_ix] >> 1) : 0u) : (unsigned)_R; (v)[_h][_i] = _r * (unsigned)lda * 2u + (unsigned)_C * 2u; } } } while (0)
#define GM_VA(arr, h) (arr)[Prob::GATHER ? (h) : 0]
    UnitX cur, nxt; int ui = 0;
    if (!P.next(0, cur)) return;
    f32x4 acc[2][2][4][2];
#pragma unroll
    for (int a = 0; a < 2; ++a)
#pragma unroll
        for (int b = 0; b < 2; ++b)
#pragma unroll
            for (int m = 0; m < 4; ++m)
#pragma unroll
                for (int n = 0; n < 2; ++n) acc[a][b][m][n] = (f32x4){0.f, 0.f, 0.f, 0.f};
    bf16x8 At[4][2], B0[2][2], B1[2][2];
    unsigned vA[2][2];
    GM_LAS u32x4* nv_slot = (GM_LAS u32x4*)(lds + STAGE_BYTES) + tid;
    GM_VOFF(cur, vA);
    {
        const char* a0 = GM_APTR(cur, 0); const char* b0 = cur.B;
        GM_STAGE(GM_SB(0, 0), b0, voffB); GM_STAGE(GM_SB(0, 1), b0 + hstepB, voffB); GM_STAGE(GM_SA(0, 0), a0, GM_VA(vA, 0)); GM_STAGE(GM_SA(0, 1), a0 + hstepA, GM_VA(vA, 1));
        if (wr == 1) GM_BAR;
        GM_WAIT_V(2); GM_BAR;
        GM_STAGE(GM_SB(1, 0), b0 + kstep, voffB); GM_STAGE(GM_SA(1, 0), a0 + kstep, GM_VA(vA, 0)); GM_STAGE(GM_SB(1, 1), b0 + hstepB + kstep, voffB);
        GM_WAIT_V(6); GM_BAR;
    }
    for (;;) {
        const bool has_next = P.next(ui + 1, nxt);
        if (!has_next) nxt = cur;
        if (Prob::GATHER) { unsigned nv_[2][2]; GM_VOFF(nxt, nv_); *nv_slot = (u32x4){nv_[0][0], nv_[0][1], nv_[1][0], nv_[1][1]}; }
        for (int t = 0; t < nt; t += 2) {
            const bool last = (t == nt - 2);
            if constexpr (Epi::HAS_MID) { if (t == 8 || t == 16) E.mid(acc, cur, t, wr, wc, fr, fq); }
            const char* a1 = GM_APTR(cur, t + 1);
            const char* a2 = last ? GM_APTR(nxt, 0) : GM_APTR(cur, t + 2);
            const char* b2 = last ? nxt.B : cur.B + (size_t)(t + 2) * kstep;
            const char* a3 = a2 + kstep; const char* b3 = b2 + kstep;
            unsigned v2[2][2];
            if (Prob::GATHER && last) { const u32x4 q_ = *nv_slot; v2[0][0] = q_.x; v2[0][1] = q_.y; v2[1][0] = q_.z; v2[1][1] = q_.w; }
            else {
#pragma unroll
                for (int h = 0; h < 2; ++h)
#pragma unroll
                    for (int i = 0; i < 2; ++i) v2[h][i] = vA[h][i]; }
            GM_LDB(B0, 0, 0); GM_LDB(B1, 0, 1); GM_SCHED; GM_LDA(At, 0, 0); GM_STAGE(GM_SA(1, 1), a1 + hstepA, GM_VA(vA, 1));
            GM_WAIT_V(8); GM_WAIT_L(0); GM_BAR; GM_MMA(0, 0, At, B0); GM_MMA(0, 1, At, B1); GM_BAR; GM_SCHED;
            GM_LDA(At, 0, 1); GM_STAGE(GM_SB(0, 0), b2, voffB); GM_STAGE(GM_SB(0, 1), b2 + hstepB, voffB); GM_STAGE(GM_SA(0, 0), a2, GM_VA(v2, 0));
            GM_WAIT_V(8); GM_WAIT_L(0); GM_BAR; GM_MMA(1, 0, At, B0); GM_MMA(1, 1, At, B1); GM_BAR; GM_SCHED;
            GM_LDB(B0, 1, 0); GM_LDB(B1, 1, 1); GM_SCHED; GM_LDA(At, 1, 0); GM_STAGE(GM_SA(0, 1), a2 + hstepA, GM_VA(v2, 1));
            GM_WAIT_V(8); GM_WAIT_L(0); GM_BAR; GM_MMA(0, 0, At, B0); GM_MMA(0, 1, At, B1); GM_BAR; GM_SCHED;
            GM_LDA(At, 1, 1); GM_STAGE(GM_SB(1, 0), b3, voffB); GM_STAGE(GM_SB(1, 1), b3 + hstepB, voffB); GM_STAGE(GM_SA(1, 0), a3, GM_VA(v2, 0));
            GM_WAIT_V(8); GM_WAIT_L(0); GM_BAR; GM_MMA(1, 0, At, B0); GM_MMA(1, 1, At, B1); GM_BAR; GM_SCHED;
        }
        if (wr == 0) GM_BAR;
        E(acc, cur, wr, wc, fr, fq);
        if (!has_next) break;
#pragma unroll
        for (int a = 0; a < 2; ++a)
#pragma unroll
            for (int b = 0; b < 2; ++b)
#pragma unroll
                for (int m = 0; m < 4; ++m)
#pragma unroll
                    for (int n = 0; n < 2; ++n) acc[a][b][m][n] = (f32x4){0.f, 0.f, 0.f, 0.f};
        cur = nxt; ++ui;
        if (Prob::GATHER) { const u32x4 q_ = *nv_slot; vA[0][0] = q_.x; vA[0][1] = q_.y; vA[1][0] = q_.z; vA[1][1] = q_.w; }
        if (wr == 1) GM_BAR;
    }
    GM_WAIT_V(0);
    GM_BAR;
#undef GM_SA
#undef GM_SB
#undef GM_STAGE
#undef GM_LDA
#undef GM_LDB
#undef GM_MMA
#undef GM_WAIT_V
#undef GM_WAIT_L
#undef GM_BAR
#undef GM_SCHED
#undef GM_APTR
#undef GM_VOFF
#undef GM_VA
}
}

#ifndef IXDRY
#define IXDRY 0
#endif
#ifndef IXMIXON
#define IXMIXON 1
#endif
constexpr int NWAVES = 8;
constexpr int S = 16384, D = 1024, NL = 2, DIN = 6216, N1 = 6400;
constexpr int NEXP = 16, DEXP = 512, CAPE = 16384;
constexpr float LN_EPS = 1e-5f;
constexpr float DN_ALPHA = 1.4142135623730951f;
constexpr float LOG2E = 1.4426950408889634f;
constexpr float Q_SCALE = 0.125f * LOG2E;
constexpr float IQ_SCALE = 0.125f;
constexpr float IW_SCALE = 0.35355339059327373f;
constexpr float MQ_SCALE = 0.08838834764831845f * LOG2E;
__host__ __device__ __forceinline__ int rot_dim(int jj) { const int g = jj >> 3, i = jj & 7; return (i < 4) ? 4 * g + i : 32 + 4 * g + (i - 4); }
__host__ __device__ __forceinline__ int in_src_col(int j) {
    if (j < 512) return j;
    if (j < 1536) { const int b = (j < 1024) ? 512 : 1024, jj = j - b; return b + (jj & ~63) + rot_dim(jj & 63); }
    if (j < 2048) return j;
    if (j < 2560) { const int jj = j - 2048; return 2048 + (jj & ~63) + rot_dim(jj & 63); }
    if (j < 3072) return 2632 + (j - 2560);
    if (j < 6144) return 3144 + (j - 3072);
    if (j < 6208) return 2560 + rot_dim(j - 6144);
    if (j < 6216) return 2624 + (j - 6208);
    return -1;
}
constexpr size_t MiB = 1u << 20;
constexpr size_t WS_CTL = 0, CTL_ZERO_BYTES = 128 * 1024;
constexpr size_t WS_RCOS = 1 * MiB, WS_RSIN = 3 * MiB;
constexpr size_t WS_MEMK = 5 * MiB, WS_MEMV = 5 * MiB + 512 * 1024;
constexpr size_t WS_TOK = 6 * MiB, WS_GL = 8 * MiB;
constexpr size_t WS_BIAS = 10 * MiB;
constexpr size_t WS_WIN = 11 * MiB, WIN_BYTES = (size_t)N1 * D * 2;
constexpr size_t WS_WBR = 36 * MiB, WBR_BYTES = (size_t)D * 1536 * 2;
constexpr size_t WS_WOUT = 42 * MiB, WOUT_BYTES = (size_t)D * D * 2;
constexpr size_t WS_XB = 46 * MiB;
constexpr size_t WS_PD = 78 * MiB;
constexpr size_t WS_MASK = 94 * MiB;
constexpr size_t WS_PU = 126 * MiB, WS_Q = 142 * MiB, WS_K = 158 * MiB, WS_V = 174 * MiB, WS_IQ = 190 * MiB, WS_MQ = 206 * MiB;
static_assert(WS_Q == WS_PU + 16 * MiB && WS_K == WS_PU + 32 * MiB && WS_V == WS_PU + 48 * MiB && WS_IQ == WS_PU + 64 * MiB && WS_MQ == WS_PU + 80 * MiB, "segment spacing");
constexpr size_t WS_IK = 222 * MiB, WS_IW = 224 * MiB, WS_GATE = 225 * MiB, WS_WMEM = 321 * MiB, WS_MEMB = 325 * MiB, WS_END = 326 * MiB;
constexpr size_t WS_W13 = 126 * MiB, WS_W2T = 158 * MiB, WS_H = 174 * MiB, WS_O2 = 210 * MiB;
static_assert(WS_WIN + 2 * WIN_BYTES <= WS_WBR && WS_WBR + 2 * WBR_BYTES <= WS_WOUT && WS_WOUT + 2 * WOUT_BYTES <= WS_XB && WS_GATE + (size_t)S * 3072 * 2 <= WS_END && WS_O2 + (size_t)S * 2 * D * 2 <= WS_END && WS_H + (size_t)36864 * 512 * 2 <= WS_O2, "d_ws map");
constexpr int CW_TMO = 0, CW_BAR = 4096, CW_ECNT = 16384;
static_assert((CW_ECNT + 4 * 16 * 64) * 4 <= (int)CTL_ZERO_BYTES, "control words inside the per-call memset");
constexpr int LDS_BYTES = 163840, LDSCTL_OFF = LDS_BYTES - 256;

#define GAS __attribute__((address_space(1)))
#define LAS __attribute__((address_space(3)))
typedef unsigned short bf16;
typedef unsigned v4u __attribute__((ext_vector_type(4)));
typedef float f32x4 __attribute__((ext_vector_type(4)));
typedef float f32x16 __attribute__((ext_vector_type(16)));
typedef short bf16x8 __attribute__((ext_vector_type(8)));
#define LDS_WAIT() asm volatile("s_waitcnt lgkmcnt(0)" ::: "memory")
#define VM_WAIT() asm volatile("s_waitcnt vmcnt(0)" ::: "memory")
__device__ __forceinline__ unsigned f2bf(float f) { unsigned u = __builtin_bit_cast(unsigned, f); return (u + 0x7fffu + ((u >> 16) & 1u)) >> 16; }
__device__ __forceinline__ unsigned pk2(float lo, float hi) { return f2bf(lo) | (f2bf(hi) << 16); }
__device__ __forceinline__ float wave_sum(float v) {
#pragma unroll
    for (int o = 1; o < 64; o <<= 1) v += __shfl_xor(v, o);
    return v;
}
namespace attn_body {
using bf16=__hip_bfloat16;
using bf16x8=__attribute__((ext_vector_type(8)))short;
using s16x4=__attribute__((ext_vector_type(4)))short;
using f32x16=__attribute__((ext_vector_type(16)))float;
using u32x4=__attribute__((ext_vector_type(4)))unsigned;
using u32x16_t=__attribute__((ext_vector_type(16)))unsigned;
constexpr int BATCH=1,NHEAD=8,SEQ=16384,D=64,DM=NHEAD*D;
constexpr int NW=8,QBLK=32,QB=QBLK*NW,KVBLK=64,NQB=SEQ/QB;
constexpr int ATTN_PITCH=DM, ATTN_UNIT_ROWS=QB;
__device__ __forceinline__ int crow(int r,int hi){return (r&3)+8*(r>>2)+4*hi;}
#define SBAR() __builtin_amdgcn_sched_barrier(0)
__device__ __forceinline__ void cmask(f32x16&p0,f32x16&p1,int jb,int qrel,int hi){
  const float NEG=-INFINITY; int kb=64*jb+4*hi;
  #pragma unroll
  for(int r=0;r<16;++r){int kv=kb+(r&3)+8*(r>>2); if(kv>qrel)p0[r]=NEG; if(kv+32>qrel)p1[r]=NEG;}
}

constexpr int NSLOT=3, SLOTB=8192;
constexpr int LDS_K=0, LDS_V=NSLOT*SLOTB, LDS_WS=2*NSLOT*SLOTB, LDS_OST=LDS_WS+NW*64*4, LDS_BYTES=LDS_OST+NW*4096;
constexpr float C2=0.125f*1.4426950408889634f;
__device__ __forceinline__ void glds16(const void*gsrc,unsigned lds_dst){unsigned keep;
  asm volatile("s_mov_b32 %0, m0\n\ts_mov_b32 m0, %2\n\ts_nop 0\n\tglobal_load_lds_dwordx4 %1, off\n\ts_mov_b32 m0, %0":"=&s"(keep):"v"(gsrc),"s"(lds_dst):"memory");}
__device__ __forceinline__ float max3f(float a,float b,float c){float r;asm("v_max3_f32 %0, %1, %2, %3":"=v"(r):"v"(a),"v"(b),"v"(c));return r;}
__device__ __forceinline__ float max2f(float a,float b){float r;asm("v_max_f32_e32 %0, %1, %2":"=v"(r):"v"(a),"v"(b));return r;}
__device__ __forceinline__ float fadd_s(float a,float b){float r;asm("v_add_f32_e32 %0, %1, %2":"=v"(r):"v"(a),"v"(b));return r;}
__device__ __forceinline__ float fsub_s(float a,float b){float r;asm("v_sub_f32_e32 %0, %1, %2":"=v"(r):"v"(a),"v"(b));return r;}
typedef float f32x2_t __attribute__((ext_vector_type(2))); typedef __bf16 bf16x2_t __attribute__((ext_vector_type(2)));
__device__ __forceinline__ unsigned cvtpk_s(float lo,float hi){f32x2_t v={lo,hi};bf16x2_t b=__builtin_convertvector(v,bf16x2_t);return __builtin_bit_cast(unsigned,b);}
#define WAIT_BAR(N) asm volatile("s_waitcnt vmcnt(" #N ") lgkmcnt(0)\n\ts_barrier":::"memory")

__device__ __forceinline__ void qkt(f32x16&p0,f32x16&p1,const char*Kslot,const bf16x8*qr,const f32x16&negm,int r32,int hi){
  const char*kb=Kslot+hi*1024+r32*16;
  #pragma unroll
  for(int d0=0;d0<4;++d0){
    const bf16x8 b0=*reinterpret_cast<const bf16x8*>(kb+d0*2048);
    const bf16x8 b1=*reinterpret_cast<const bf16x8*>(kb+d0*2048+512);
    if(d0==0){p0=__builtin_amdgcn_mfma_f32_32x32x16_bf16(b0,qr[0],negm,0,0,0);p1=__builtin_amdgcn_mfma_f32_32x32x16_bf16(b1,qr[0],negm,0,0,0);}
    else{p0=__builtin_amdgcn_mfma_f32_32x32x16_bf16(b0,qr[d0],p0,0,0,0);p1=__builtin_amdgcn_mfma_f32_32x32x16_bf16(b1,qr[d0],p1,0,0,0);}}
}
typedef __attribute__((address_space(3))) const char* lds_cptr;
typedef short v4i16_t __attribute__((ext_vector_type(4)));
__device__ __forceinline__ void kload8(bf16x8*kf,lds_cptr kp){
  kf[0]=*(const __attribute__((address_space(3))) bf16x8*)(kp);      kf[1]=*(const __attribute__((address_space(3))) bf16x8*)(kp+512);
  kf[2]=*(const __attribute__((address_space(3))) bf16x8*)(kp+2048); kf[3]=*(const __attribute__((address_space(3))) bf16x8*)(kp+2560);
  kf[4]=*(const __attribute__((address_space(3))) bf16x8*)(kp+4096); kf[5]=*(const __attribute__((address_space(3))) bf16x8*)(kp+4608);
  kf[6]=*(const __attribute__((address_space(3))) bf16x8*)(kp+6144); kf[7]=*(const __attribute__((address_space(3))) bf16x8*)(kp+6656);
}
__device__ __forceinline__ void kload2(bf16x8*kf,lds_cptr kp,int j){ kf[2*j]=*(const __attribute__((address_space(3))) bf16x8*)(kp+j*2048); kf[2*j+1]=*(const __attribute__((address_space(3))) bf16x8*)(kp+j*2048+512); }
__device__ __forceinline__ s16x4 vtr(lds_cptr p){ return __builtin_bit_cast(s16x4,__builtin_amdgcn_ds_read_tr16_b64_v4i16((__attribute__((address_space(3))) v4i16_t*)p)); }
__device__ __forceinline__ float rowmax(const f32x16&p0,const f32x16&p1){
  float a=max3f(p0[0],p0[1],p1[0]),b=max3f(p0[2],p0[3],p1[1]);a=max3f(a,p1[2],p1[3]);
  #pragma unroll
  for(int r=4;r<16;r+=4){a=max3f(a,p0[r],p0[r+1]);b=max3f(b,p0[r+2],p0[r+3]);a=max3f(a,p1[r],p1[r+1]);b=max3f(b,p1[r+2],p1[r+3]);}
  const float m=max2f(a,b);
  auto rr=__builtin_amdgcn_permlane32_swap(__float_as_uint(m),__float_as_uint(m),false,false);
  return max2f(__uint_as_float(rr[0]),__uint_as_float(rr[1]));
}
__device__ __forceinline__ void pv(f32x16*o,int vb,bf16x8 pa0,bf16x8 pa1,bf16x8 pa2,bf16x8 pa3){
  #pragma unroll
  for(int d0=0;d0<2;++d0){s16x4 lo[4],hi[4];
    #pragma unroll
    for(int ks=0;ks<4;++ks){
      asm volatile("ds_read_b64_tr_b16 %0,%1 offset:%c2":"=&v"(lo[ks]):"v"(vb),"i"(d0*4096+ks*1024):"memory");
      asm volatile("ds_read_b64_tr_b16 %0,%1 offset:%c2":"=&v"(hi[ks]):"v"(vb),"i"(d0*4096+ks*1024+512):"memory");}
    asm volatile("s_waitcnt lgkmcnt(0)":::"memory");SBAR();
    #define PK(k) (bf16x8){lo[k][0],lo[k][1],lo[k][2],lo[k][3],hi[k][0],hi[k][1],hi[k][2],hi[k][3]}
    o[d0]=__builtin_amdgcn_mfma_f32_32x32x16_bf16(pa0,PK(0),o[d0],0,0,0);
    o[d0]=__builtin_amdgcn_mfma_f32_32x32x16_bf16(pa1,PK(1),o[d0],0,0,0);
    o[d0]=__builtin_amdgcn_mfma_f32_32x32x16_bf16(pa2,PK(2),o[d0],0,0,0);
    o[d0]=__builtin_amdgcn_mfma_f32_32x32x16_bf16(pa3,PK(3),o[d0],0,0,0);
    #undef PK
  }
}

#ifndef ATTN_STORE16
#define ATTN_STORE16(p,v) (*(u32x4*)(p)=(v))
#endif
template<int THRL> __device__ __forceinline__ void attn_unit(int b,int h,int qb,const bf16*Q,const bf16*__restrict__ K,const bf16*__restrict__ V,bf16*O,const unsigned long long*MT,int wave_id,char*shm){
  int tid_=(wave_id<<6)|gm::gm_lane_id(); asm volatile("":"+v"(tid_)); const int tid=tid_,lane=tid&63,r32=lane&31,hi=lane>>5; const int wid=__builtin_amdgcn_readfirstlane(tid>>6);
  const long rowbase=(long)b*SEQ; const int q0=qb*QB;
  const bf16*Qw=Q+(rowbase+q0+wid*QBLK)*DM+h*D;
  const bf16*Kh=K+rowbase*DM+h*D,*Vh=V+rowbase*DM+h*D;
  const unsigned lds0=(unsigned)(uintptr_t)shm;
  float*wsf=(float*)(shm+LDS_WS)+wid*64;
  const bf16*ksrc=Kh+(long)lane*DM+wid*8;
  const bf16*vsrc=Vh+(long)(16*(wid&3)+(lane>>2))*DM+(wid>>2)*32+(lane&3)*8;
  const unsigned kdst=lds0+LDS_K+wid*1024, vdst=lds0+LDS_V+wid*1024;
  #define DMA_K(t,slot) glds16(ksrc+(long)(t)*KVBLK*DM,(unsigned)__builtin_amdgcn_readfirstlane(kdst+(slot)))
  #define DMA_V(t,slot) glds16(vsrc+(long)(t)*KVBLK*DM,(unsigned)__builtin_amdgcn_readfirstlane(vdst+(slot)))
  const int vb0=(int)(lds0+LDS_V)+((lane>>4)&1)*32+(lane&3)*8+(4*hi+((lane&15)>>2))*64;
  const char*Kbase=shm+LDS_K; bf16x8 kf[8];
  const lds_cptr shm3=(lds_cptr)shm; const lds_cptr kp0=shm3+LDS_K+hi*1024+r32*16; const lds_cptr vp0=shm3+LDS_V+((lane>>4)&1)*32+(lane&3)*8+(4*hi+((lane&15)>>2))*64;
  const int NT=(q0+QB)/KVBLK;
  { const unsigned pd_=(unsigned)__builtin_amdgcn_readfirstlane((int)(lds0+131072+wid*1024)); const char*mb_=(const char*)(MT+((size_t)(qb*8+wid)*256)*32)+lane*16; glds16(mb_,pd_); glds16(mb_+1024,pd_); }
  DMA_K(0,0);DMA_V(0,0);DMA_K(1,SLOTB);
  bf16x8 qr[4];
  #pragma unroll
  for(int d0=0;d0<4;++d0)qr[d0]=*reinterpret_cast<const bf16x8*>(&Qw[(long)r32*DM+d0*16+hi*8]);
  float mhat=0.f,l_reg=0.f;f32x16 o[2];o[0]=f32x16{};o[1]=f32x16{};f32x16 negm=f32x16{};asm volatile("":"+v"(negm));
  const unsigned long long*mw=MT+((size_t)(qb*8+wid)*256)*32;
  u32x16_t mk0,mk1;
  typedef const __attribute__((address_space(4))) u32x16_t* mcptr_t;
  #define MLOAD(t,half) do{ mcptr_t mp_=(mcptr_t)(mw+(size_t)(t)*32+(half)*16); mk0=mp_[0]; mk1=mp_[1]; }while(0)
  #define MSEL(M,i,v) (__builtin_amdgcn_inverse_ballot_w64(((unsigned long long)M[2*(i)+1]<<32)|M[2*(i)])?(v):-INFINITY)
  #define MAPPLY(PX) do{ \
    _Pragma("unroll") for(int r=0;r<8;++r){PX[r]=MSEL(mk0,r,PX[r]);PX[8+r]=MSEL(mk1,r,PX[8+r]);} }while(0)
  #define CMASK(P0,P1,t) do{}while(0)
  MLOAD(0,0);
  const unsigned mpf_dst=(unsigned)__builtin_amdgcn_readfirstlane((int)(lds0+131072+wid*1024));
  #define MPF(t) do{ if((((t)&3)==0)&&((t)+11<NT)){ glds16((const char*)(mw+(size_t)((t)+8)*32)+lane*16,mpf_dst); } }while(0)
  bool resc=false;
  #define START(P0,P1) do{ const float rm=rowmax(P0,P1); resc=false; \
    { const float dl=rm; mhat=fadd_s(mhat,dl); \
      _Pragma("unroll") for(int r=0;r<16;++r){P0[r]=fsub_s(P0[r],dl);P1[r]=fsub_s(P1[r],dl);} \
      _Pragma("unroll") for(int r=0;r<16;++r)negm[r]=-mhat; asm volatile("":"+v"(negm)); } \
    MAPPLY(P0); MLOAD(0,1); \
    _Pragma("unroll") for(int r=0;r<16;++r)P0[r]=__builtin_amdgcn_exp2f(P0[r]); \
    MAPPLY(P1); MLOAD(1,0); }while(0)
  #define RESC() do{ if(resc){ asm volatile("s_waitcnt lgkmcnt(0)":::"memory"); \
      _Pragma("unroll") for(int d_=0;d_<2;++d_) _Pragma("unroll") for(int r=0;r<16;++r)o[d_][r]*=wsf[crow(r,hi)]; } }while(0)
  f32x16 pA0,pA1,pB0,pB1;
  int sl_prev=0,sl_cur=0,sl_next=SLOTB;
  #define ROT() do{sl_prev=sl_cur;sl_cur=sl_next;sl_next=(sl_next==(NSLOT-1)*SLOTB)?0:sl_next+SLOTB;}while(0)
  DMA_K(2,2*SLOTB);
  WAIT_BAR(3);
  qkt(pA0,pA1,Kbase,qr,negm,r32,hi);asm volatile("s_nop 15\n\ts_nop 7":"+v"(pA0),"+v"(pA1));CMASK(pA0,pA1,0);
  START(pA0,pA1);
  _Pragma("unroll") for(int r=0;r<16;++r)pA1[r]=__builtin_amdgcn_exp2f(pA1[r]);
  WAIT_BAR(0);
  DMA_K(3,0);DMA_V(1,SLOTB);
  ROT();
  kload8(kf,kp0+sl_cur);
  WAIT_BAR(2);
  s16x4 vlo[8],vhi[8]; u32x4 pw0,pw1,pw2,pw3;
  #define PKW(P,B) cvtpk_s(P[B],P[B+1])
  #define PAF(k) __builtin_bit_cast(bf16x8,pw##k)
  #define VFR(i) (bf16x8){vlo[i][0],vlo[i][1],vlo[i][2],vlo[i][3],vhi[i][0],vhi[i][1],vhi[i][2],vhi[i][3]}
  #define PIN(x) asm volatile("":"+v"(x))
  #define MX3(a,b,c) __builtin_fmaxf(__builtin_fmaxf((a),(b)),(c))
  #define GAPA(MF,A0,A1,A2,A3,W0,W1,PW) do{ MF; sacc+=A0; sacc+=A1; sacc+=A2; sacc+=A3; PIN(sacc); W0; W1; PIN(PW); SBAR(); }while(0)
  #define EX(v) __builtin_amdgcn_exp2f(v)
  #define GAPB(MF,X,B) do{ MF; X[B]=EX(X[B]); X[B+1]=EX(X[B+1]); X[B+2]=EX(X[B+2]); X[B+3]=EX(X[B+3]); PIN(X); SBAR(); }while(0)
  #define VRD(i) do{ vlo[i]=vtr(vp_+(((i)>>2)*4096+((i)&3)*1024)); vhi[i]=vtr(vp_+(((i)>>2)*4096+((i)&3)*1024+512)); }while(0)
  #define KRD(G,j) do{ if(G){ kload2(kf,kp0+sl_next,j); SBAR(); } }while(0)
  #define STEP(C0,C1,P0,P1,t,GK,GV,GL) do{ SBAR(); MPF(t); \
    const lds_cptr vp_=vp0+sl_prev; \
    VRD(0); SBAR(); float sacc=(P0[0]+P0[1]); \
    GAPA(C0=__builtin_amdgcn_mfma_f32_32x32x16_bf16(kf[0],qr[0],negm,0,0,0), P0[2],P0[3],P0[4],P0[5],     pw0[0]=PKW(P0,0), pw0[1]=PKW(P0,2), pw0); \
    VRD(4); SBAR(); GAPA(C1=__builtin_amdgcn_mfma_f32_32x32x16_bf16(kf[1],qr[0],negm,0,0,0), P0[6],P0[7],P0[8],P0[9],     pw0[2]=PKW(P0,4), pw0[3]=PKW(P0,6), pw0); \
    VRD(1); SBAR(); GAPA(C0=__builtin_amdgcn_mfma_f32_32x32x16_bf16(kf[2],qr[1],C0,0,0,0),   P0[10],P0[11],P0[12],P0[13], pw1[0]=PKW(P0,8), pw1[1]=PKW(P0,10), pw1); \
    VRD(5); SBAR(); GAPA(C1=__builtin_amdgcn_mfma_f32_32x32x16_bf16(kf[3],qr[1],C1,0,0,0),   P0[14],P0[15],P1[0],P1[1],   pw1[2]=PKW(P0,12),pw1[3]=PKW(P0,14), pw1); \
    VRD(2); SBAR(); GAPA(C0=__builtin_amdgcn_mfma_f32_32x32x16_bf16(kf[4],qr[2],C0,0,0,0),   P1[2],P1[3],P1[4],P1[5],     pw2[0]=PKW(P1,0), pw2[1]=PKW(P1,2), pw2); \
    VRD(6); SBAR(); GAPA(C1=__builtin_amdgcn_mfma_f32_32x32x16_bf16(kf[5],qr[2],C1,0,0,0),   P1[6],P1[7],P1[8],P1[9],     pw2[2]=PKW(P1,4), pw2[3]=PKW(P1,6), pw2); \
    VRD(3); SBAR(); GAPA(C0=__builtin_amdgcn_mfma_f32_32x32x16_bf16(kf[6],qr[3],C0,0,0,0),   P1[10],P1[11],P1[12],P1[13], pw3[0]=PKW(P1,8), pw3[1]=PKW(P1,10), pw3); \
    VRD(7); SBAR(); GAPA(C1=__builtin_amdgcn_mfma_f32_32x32x16_bf16(kf[7],qr[3],C1,0,0,0),   P1[14],P1[15],0.f,0.f,       pw3[2]=PKW(P1,12),pw3[3]=PKW(P1,14), pw3); \
    l_reg+=sacc; \
    if(GK){DMA_K((t)+3,sl_cur);} if(GV){DMA_V((t)+1,sl_next);} \
    CMASK(C0,C1,t); \
    { float a=MX3(C0[0],C0[1],C1[0]),b=MX3(C0[2],C0[3],C1[1]); a=MX3(a,C1[2],C1[3]); \
      _Pragma("unroll") for(int r=4;r<16;r+=4){a=MX3(a,C0[r],C0[r+1]);b=MX3(b,C0[r+2],C0[r+3]);a=MX3(a,C1[r],C1[r+1]);b=MX3(b,C1[r+2],C1[r+3]);} \
      float rm=__builtin_fmaxf(a,b); { auto rr=__builtin_amdgcn_permlane32_swap(__float_as_uint(rm),__float_as_uint(rm),false,false); rm=__builtin_fmaxf(__uint_as_float(rr[0]),__uint_as_float(rr[1])); } \
      resc=false; \
      if(__builtin_expect(__any(rm>(float)THRL),0)){ const float dl=__builtin_fmaxf(rm,0.f); mhat+=dl; \
        _Pragma("unroll") for(int r=0;r<16;++r){C0[r]-=dl;C1[r]-=dl;} \
        _Pragma("unroll") for(int r=0;r<16;++r)negm[r]=-mhat; asm volatile("":"+v"(negm)); \
        const float f=__builtin_amdgcn_exp2f(-dl); l_reg*=f; if(hi==0)wsf[r32]=f; resc=true; } } \
    MAPPLY(C0); MLOAD(t,1); \
    SBAR(); \
    GAPB(o[0]=__builtin_amdgcn_mfma_f32_32x32x16_bf16(PAF(0),VFR(0),o[0],0,0,0), C0,0); \
    GAPB(o[1]=__builtin_amdgcn_mfma_f32_32x32x16_bf16(PAF(0),VFR(4),o[1],0,0,0), C0,4); \
    KRD(GL,0); GAPB(o[0]=__builtin_amdgcn_mfma_f32_32x32x16_bf16(PAF(1),VFR(1),o[0],0,0,0), C0,8); \
    KRD(GL,1); GAPB(o[1]=__builtin_amdgcn_mfma_f32_32x32x16_bf16(PAF(1),VFR(5),o[1],0,0,0), C0,12); \
    MAPPLY(C1); if((t)+1<NT){MLOAD((t)+1,0);} SBAR(); \
    KRD(GL,2); GAPB(o[0]=__builtin_amdgcn_mfma_f32_32x32x16_bf16(PAF(2),VFR(2),o[0],0,0,0), C1,0); \
    KRD(GL,3); GAPB(o[1]=__builtin_amdgcn_mfma_f32_32x32x16_bf16(PAF(2),VFR(6),o[1],0,0,0), C1,4); \
    GAPB(o[0]=__builtin_amdgcn_mfma_f32_32x32x16_bf16(PAF(3),VFR(3),o[0],0,0,0), C1,8); \
    GAPB(o[1]=__builtin_amdgcn_mfma_f32_32x32x16_bf16(PAF(3),VFR(7),o[1],0,0,0), C1,12); \
    }while(0)
  int t=1;
  for(;t+5<NT;t+=2){
    STEP(pB0,pB1,pA0,pA1,t,true,true,true);     WAIT_BAR(2); RESC(); ROT();
    STEP(pA0,pA1,pB0,pB1,t+1,true,true,true);   WAIT_BAR(2); RESC(); ROT();
  }
  #define ENDW(tt) do{ if((tt)+3<NT){WAIT_BAR(2);} else if((tt)+2<NT){WAIT_BAR(1);} else {WAIT_BAR(0);} }while(0)
  for(;t+1<NT;t+=2){
    STEP(pB0,pB1,pA0,pA1,t,(t+3<NT),(t+1<NT),(t+1<NT));       ENDW(t);   RESC(); ROT();
    STEP(pA0,pA1,pB0,pB1,t+1,(t+4<NT),(t+2<NT),(t+2<NT));     ENDW(t+1); RESC(); ROT();
  }
  STEP(pB0,pB1,pA0,pA1,NT-1,false,false,false); RESC();
  { float sacc=pB0[0]+pB0[1]; _Pragma("unroll") for(int r=2;r<16;++r)sacc+=pB0[r]; _Pragma("unroll") for(int r=0;r<16;++r)sacc+=pB1[r]; l_reg+=sacc;
    pw0=(u32x4){PKW(pB0,0),PKW(pB0,2),PKW(pB0,4),PKW(pB0,6)};pw1=(u32x4){PKW(pB0,8),PKW(pB0,10),PKW(pB0,12),PKW(pB0,14)};pw2=(u32x4){PKW(pB1,0),PKW(pB1,2),PKW(pB1,4),PKW(pB1,6)};pw3=(u32x4){PKW(pB1,8),PKW(pB1,10),PKW(pB1,12),PKW(pB1,14)};
    SBAR(); pv(o,vb0+sl_cur,PAF(0),PAF(1),PAF(2),PAF(3)); }
  #undef PKW
  #undef PAF
  #undef VFR
  #undef PIN
  #undef MX3
  #undef GAPA
  #undef GAPB
  #undef EX
  #undef VRD
  #undef KRD
  #undef STEP
  #undef ENDW
  {auto rr=__builtin_amdgcn_permlane32_swap(__float_as_uint(l_reg),__float_as_uint(l_reg),false,false);l_reg=__uint_as_float(rr[0])+__uint_as_float(rr[1]);}
  if(hi==0)wsf[32+r32]=l_reg;asm volatile("s_waitcnt lgkmcnt(0)":::"memory");
  float rli[16];
  #pragma unroll
  for(int r=0;r<16;++r)rli[r]=__builtin_amdgcn_rcpf(wsf[32+crow(r,hi)]);
  bf16*Ow=O+(rowbase+q0+wid*QBLK)*DM+h*D;
  { bf16*stg=(bf16*)(shm+LDS_OST)+wid*2048;
    #pragma unroll
    for(int r=0;r<16;++r){const int orow=crow(r,hi);
      #pragma unroll
      for(int d0=0;d0<2;++d0)stg[orow*64+d0*32+r32]=__float2bfloat16(o[d0][r]*rli[r]);}
    asm volatile("s_waitcnt lgkmcnt(0)":::"memory");
    #pragma unroll
    for(int i=0;i<4;++i){const int row=i*8+(lane>>3),ch=lane&7; const u32x4 v=*(const u32x4*)(stg+row*64+ch*8); ATTN_STORE16(Ow+(long)row*DM+ch*8,v);} }
  asm volatile("s_waitcnt lgkmcnt(0)\n\ts_barrier":::"memory");
  #undef DMA_K
  #undef DMA_V
  #undef CMASK
  #undef MPF
  #undef MLOAD
  #undef MSEL
  #undef MAPPLY
  #undef START
  #undef RESC
  #undef ROT
}
constexpr int ATTN_LDS_BYTES=LDS_BYTES;
struct AttnTensors { const bf16* Q; const bf16* K; const bf16* V; bf16* O; const unsigned long long* MT; int wave; };
struct AttnUnit { int bh; int qb; };
struct StaticOrder {
  int vcu,G;
  __device__ __forceinline__ explicit StaticOrder(int grid,int block):vcu((grid%8==0)?(block%8)*(grid/8)+block/8:block),G(grid){}
  __device__ __forceinline__ bool next(int i,AttnUnit&u)const{ const int p=vcu+(i>>1)*G; if(p>=256)return false; const int s=p&31; u.bh=p>>5; u.qb=(i&1)?63-s:s; return true; }
  __device__ __forceinline__ void a_ready(const AttnUnit&)const{}
  __device__ __forceinline__ void done(const AttnUnit&)const{}
};
template<class Sched,int THRL=8> __device__ __forceinline__ void attn_phase(char*lds,const AttnTensors&T,const Sched&S){
  AttnUnit u;
  for(int i=0;S.next(i,u);++i){ S.a_ready(u); attn_unit<THRL>(u.bh/NHEAD,u.bh%NHEAD,u.qb,T.Q,T.K,T.V,T.O,T.MT,T.wave,lds); S.done(u); }
}
#undef SBAR
#undef WAIT_BAR
}


namespace gm {
template <int NSEG_> struct ProbDense {
    static constexpr int NSEG = NSEG_; static constexpr bool GATHER = false;
    const char* A0; const char* A1; const char* A2; const char* Bt; int M, N, K, lda, G, c;
    __device__ __forceinline__ bool next(int i, UnitX& u) const {
        int pm, pn; if (!static_unit((long)i * G + c, M / BM, N / BM, pm, pn)) return false;
        u.pm = pm; u.pn = pn; u.e = 0; u.blk = 0; u.nvalid = BM; u.rows = nullptr;
        const size_t ra = (size_t)pm * BM * lda * 2;
        u.A0 = A0 + ra; u.A1 = (NSEG_ == 3) ? A1 + ra : nullptr; u.A2 = (NSEG_ == 3) ? A2 + ra : nullptr; u.B = Bt + (size_t)pn * BM * K * 2; return true;
    }
};
template <bool UP> struct ProbMoe {
    static constexpr int NSEG = 1; static constexpr bool GATHER = UP;
    const char* A; const char* W; const int* toks; int K, lda, G, c; const LAS int* tl;
    __device__ __forceinline__ bool next(int i, UnitX& u) const {
        const long L = (long)i * G + c; const int T = tl[NEXP]; if (L >= (long)T * 4) return false;
        const int j = (int)(L >> 2), pn = (int)(L & 3); int e = 0;
#pragma unroll
        for (int k = 1; k < NEXP; ++k) e += (j >= tl[k]) ? 1 : 0;
        const int blk = j - tl[e]; { const int rem = tl[17 + e] - blk * BM; u.nvalid = rem < BM ? rem : BM; }
        u.pm = j; u.pn = pn; u.e = e; u.blk = blk; u.A1 = nullptr; u.A2 = nullptr;
        if (UP) { u.A0 = A; u.rows = toks + (size_t)e * CAPE + blk * BM; u.B = W + ((size_t)e * 1024 + (size_t)pn * BM) * 1024 * 2; }
        else    { u.A0 = A + (size_t)j * BM * 512 * 2; u.rows = nullptr; u.B = W + ((size_t)e * 1024 + (size_t)pn * BM) * 512 * 2; }
        return true;
    }
};

struct EpiProj {
    static constexpr bool PERM = true, HAS_MID = false;
    unsigned char* ws; const float* bias;
    __device__ __forceinline__ void operator()(const f32x4 (&acc)[2][2][4][2], const UnitX& u, int wr, int wc, int fr, int fq) const {
        asm volatile("" : "+v"(fr), "+v"(fq));
        const int pn = u.pn, row0 = u.pm * BM + wr * 64 + fr, cw = wc * 32 + 8 * fq, bcol0 = pn * BM + cw;
        f32x4 bv[2][2];
#pragma unroll
        for (int bj = 0; bj < 2; ++bj)
#pragma unroll
            for (int n = 0; n < 2; ++n) bv[bj][n] = *(const f32x4*)(bias + bcol0 + bj * HALF + 4 * n);
        if (pn >= 12 && pn < 24) {
#pragma unroll
            for (int ai = 0; ai < 2; ++ai)
#pragma unroll
                for (int m = 0; m < 4; ++m) { bf16_t* rowp = (bf16_t*)(ws + WS_GATE) + (size_t)(row0 + ai * HALF + m * 16) * 3072 + (pn - 12) * BM + cw;
#pragma unroll
                    for (int bj = 0; bj < 2; ++bj) { f32x4 v0 = acc[ai][bj][m][0] + bv[bj][0], v1 = acc[ai][bj][m][1] + bv[bj][1];
#pragma unroll
                        for (int j = 0; j < 4; ++j) { v0[j] = __builtin_amdgcn_rcpf(1.0f + __builtin_amdgcn_exp2f(-LOG2E * v0[j])); v1[j] = __builtin_amdgcn_rcpf(1.0f + __builtin_amdgcn_exp2f(-LOG2E * v1[j])); }
                        u32x4 w; w.x = cvt_pk_bf16(v0[0], v0[1]); w.y = cvt_pk_bf16(v0[2], v0[3]); w.z = cvt_pk_bf16(v1[0], v1[1]); w.w = cvt_pk_bf16(v1[2], v1[3]);
                        *(u32x4*)(rowp + bj * HALF) = w; } }
        } else if (pn < 2 || pn == 6 || pn == 7 || pn == 10 || pn == 11) {
            bf16_t* base = (bf16_t*)(ws + WS_PU + (size_t)(pn >> 1) * (16 * MiB)); const float sc = (pn >= 10) ? MQ_SCALE : 1.0f;
#pragma unroll
            for (int ai = 0; ai < 2; ++ai)
#pragma unroll
                for (int m = 0; m < 4; ++m) { bf16_t* rowp = base + (size_t)(row0 + ai * HALF + m * 16) * 512 + (pn & 1) * BM + cw;
#pragma unroll
                    for (int bj = 0; bj < 2; ++bj) { const f32x4 v0 = (acc[ai][bj][m][0] + bv[bj][0]) * sc, v1 = (acc[ai][bj][m][1] + bv[bj][1]) * sc;
                        u32x4 w; w.x = cvt_pk_bf16(v0[0], v0[1]); w.y = cvt_pk_bf16(v0[2], v0[3]); w.z = cvt_pk_bf16(v1[0], v1[1]); w.w = cvt_pk_bf16(v1[2], v1[3]);
                        *(u32x4*)(rowp + bj * HALF) = w; } }
        } else if (pn < 10) {
            bf16_t* base = (bf16_t*)(ws + WS_PU + (size_t)(pn >> 1) * (16 * MiB)); const float sc = (pn < 4) ? Q_SCALE : ((pn < 6) ? 1.0f : IQ_SCALE); const int g = (wc & 1) * 4 + fq;
            const float* rcos = (const float*)(ws + WS_RCOS); const float* rsin = (const float*)(ws + WS_RSIN);
#pragma unroll
            for (int ai = 0; ai < 2; ++ai)
#pragma unroll
                for (int m = 0; m < 4; ++m) { const int row = row0 + ai * HALF + m * 16; bf16_t* rowp = base + (size_t)row * 512 + (pn & 1) * BM + cw;
                    f32x4 cs = *(const f32x4*)(rcos + (size_t)row * 32 + 4 * g), sn = *(const f32x4*)(rsin + (size_t)row * 32 + 4 * g);
                    asm volatile("" : "+v"(cs), "+v"(sn));
#pragma unroll
                    for (int bj = 0; bj < 2; ++bj) { const f32x4 x1 = (acc[ai][bj][m][0] + bv[bj][0]) * sc, x2 = (acc[ai][bj][m][1] + bv[bj][1]) * sc;
                        const f32x4 o1 = x1 * cs - x2 * sn, o2 = x2 * cs + x1 * sn;
                        u32x4 w; w.x = cvt_pk_bf16(o1[0], o1[1]); w.y = cvt_pk_bf16(o1[2], o1[3]); w.z = cvt_pk_bf16(o2[0], o2[1]); w.w = cvt_pk_bf16(o2[2], o2[3]);
                        *(u32x4*)(rowp + bj * HALF) = w; }
                    asm volatile("" ::: "memory"); }
        } else {
            const float* rcos = (const float*)(ws + WS_RCOS); const float* rsin = (const float*)(ws + WS_RSIN); bf16_t* ik = (bf16_t*)(ws + WS_IK); float* iw = (float*)(ws + WS_IW);
            if (wc < 2) { const int g = (wc & 1) * 4 + fq;
#pragma unroll
                for (int ai = 0; ai < 2; ++ai)
#pragma unroll
                    for (int m = 0; m < 4; ++m) { const int row = row0 + ai * HALF + m * 16;
                        const f32x4 cs = *(const f32x4*)(rcos + (size_t)row * 32 + 4 * g), sn = *(const f32x4*)(rsin + (size_t)row * 32 + 4 * g);
                        const f32x4 x1 = acc[ai][0][m][0] + bv[0][0], x2 = acc[ai][0][m][1] + bv[0][1];
                        const f32x4 o1 = x1 * cs - x2 * sn, o2 = x2 * cs + x1 * sn;
                        u32x4 w; w.x = cvt_pk_bf16(o1[0], o1[1]); w.y = cvt_pk_bf16(o1[2], o1[3]); w.z = cvt_pk_bf16(o2[0], o2[1]); w.w = cvt_pk_bf16(o2[2], o2[3]);
                        *(u32x4*)(ik + (size_t)row * 64 + cw) = w; }
            } else if (wc == 2 && fq == 0) {
#pragma unroll
                for (int ai = 0; ai < 2; ++ai)
#pragma unroll
                    for (int m = 0; m < 4; ++m) { const int row = row0 + ai * HALF + m * 16;
                        *(f32x4*)(iw + (size_t)row * 8) = (acc[ai][0][m][0] + bv[0][0]) * IW_SCALE; *(f32x4*)(iw + (size_t)row * 8 + 4) = (acc[ai][0][m][1] + bv[0][1]) * IW_SCALE; }
            }
        }
    }
};

struct EpiMerge {
    static constexpr bool PERM = true, HAS_MID = true;
    const bf16_t* gate; bf16_t* out;
    __device__ __forceinline__ void mid(f32x4 (&acc)[2][2][4][2], const UnitX& u, int t, int wr, int wc, int fr, int fq) const {
        asm volatile("" : "+v"(fr), "+v"(fq));
        const int na = (t == 8) ? 0 : 1, row0 = u.pm * BM + wr * 64 + fr, col0 = u.pn * BM + wc * 32 + 8 * fq;
#pragma unroll
        for (int ai = 0; ai < 2; ++ai)
#pragma unroll
            for (int m = 0; m < 4; ++m) { const bf16_t* gp = gate + (size_t)(row0 + ai * HALF + m * 16) * 3072 + na * 1024 + col0;
#pragma unroll
                for (int bj = 0; bj < 2; ++bj) { const u32x4 a = *(const u32x4*)(gp + bj * HALF), b = *(const u32x4*)(gp + 1024 + bj * HALF);
                    f32x4 r0, r1;
                    r0[0] = bf_lo(a.x) * __builtin_amdgcn_rcpf(fmaxf(bf_lo(b.x), 1e-30f)); r0[1] = bf_hi(a.x) * __builtin_amdgcn_rcpf(fmaxf(bf_hi(b.x), 1e-30f));
                    r0[2] = bf_lo(a.y) * __builtin_amdgcn_rcpf(fmaxf(bf_lo(b.y), 1e-30f)); r0[3] = bf_hi(a.y) * __builtin_amdgcn_rcpf(fmaxf(bf_hi(b.y), 1e-30f));
                    r1[0] = bf_lo(a.z) * __builtin_amdgcn_rcpf(fmaxf(bf_lo(b.z), 1e-30f)); r1[1] = bf_hi(a.z) * __builtin_amdgcn_rcpf(fmaxf(bf_hi(b.z), 1e-30f));
                    r1[2] = bf_lo(a.w) * __builtin_amdgcn_rcpf(fmaxf(bf_lo(b.w), 1e-30f)); r1[3] = bf_hi(a.w) * __builtin_amdgcn_rcpf(fmaxf(bf_hi(b.w), 1e-30f));
                    acc[ai][bj][m][0] *= r0; acc[ai][bj][m][1] *= r1; }
                if (m == 3) asm volatile("" ::: "memory"); }
    }
    __device__ __forceinline__ void operator()(const f32x4 (&acc)[2][2][4][2], const UnitX& u, int wr, int wc, int fr, int fq) const {
        asm volatile("" : "+v"(fr), "+v"(fq));
        const int row0 = u.pm * BM + wr * 64 + fr, col0 = u.pn * BM + wc * 32 + 8 * fq;
#pragma unroll
        for (int ai = 0; ai < 2; ++ai)
#pragma unroll
            for (int m = 0; m < 4; ++m) { const int row = row0 + ai * HALF + m * 16; const bf16_t* gp = gate + (size_t)row * 3072 + 2048 + col0; bf16_t* op = out + (size_t)row * 1024 + col0;
#pragma unroll
                for (int bj = 0; bj < 2; ++bj) { const u32x4 a = *(const u32x4*)(gp + bj * HALF);
                    const f32x4 v0 = acc[ai][bj][m][0] * (f32x4){bf_lo(a.x), bf_hi(a.x), bf_lo(a.y), bf_hi(a.y)}, v1 = acc[ai][bj][m][1] * (f32x4){bf_lo(a.z), bf_hi(a.z), bf_lo(a.w), bf_hi(a.w)};
                    u32x4 w; w.x = cvt_pk_bf16(v0[0], v0[1]); w.y = cvt_pk_bf16(v0[2], v0[3]); w.z = cvt_pk_bf16(v1[0], v1[1]); w.w = cvt_pk_bf16(v1[2], v1[3]);
                    *(u32x4*)(op + bj * HALF) = w; }
                if (m & 1) asm volatile("" ::: "memory"); }
    }
};

struct EpiMemKV {
    static constexpr bool PERM = false, HAS_MID = false;
    bf16_t* mk; bf16_t* mvt;
    __device__ __forceinline__ void operator()(const f32x4 (&acc)[2][2][4][2], const UnitX& u, int wr, int wc, int fr, int fq) const {
        asm volatile("" : "+v"(fr), "+v"(fq));
        const int row0 = wr * 64 + fr, col0 = u.pn * BM + wc * 32 + 4 * fq;
#pragma unroll
        for (int ai = 0; ai < 2; ++ai)
#pragma unroll
            for (int m = 0; m < 4; ++m) { const int row = row0 + ai * HALF + m * 16, mm = row & 15, slot = (row & ~15) + 8 * ((mm >> 2) & 1) + (mm & 3) + 4 * (mm >> 3);
#pragma unroll
                for (int bj = 0; bj < 2; ++bj)
#pragma unroll
                    for (int n = 0; n < 2; ++n) { const int c = col0 + bj * HALF + n * 16, l = c >> 10, cc = c & 1023; const f32x4 v = acc[ai][bj][m][n];
                        if (cc < 512) { const int h = cc >> 7, d = cc & 127;
                            *(unsigned long long*)(mk + ((size_t)(l * 4 + h) * 256 + row) * 128 + d) = (unsigned long long)cvt_pk_bf16(v[0], v[1]) | ((unsigned long long)cvt_pk_bf16(v[2], v[3]) << 32);
                        } else { const int h = (cc - 512) >> 7, d = (cc - 512) & 127; bf16_t* o = mvt + ((size_t)(l * 4 + h) * 128 + d) * 256 + slot; const unsigned w0 = cvt_pk_bf16(v[0], v[1]), w1 = cvt_pk_bf16(v[2], v[3]);
                            o[0] = (bf16_t)(w0 & 0xffffu); o[256] = (bf16_t)(w0 >> 16); o[512] = (bf16_t)(w1 & 0xffffu); o[768] = (bf16_t)(w1 >> 16); } } }
    }
};
struct EpiRes {
    static constexpr bool PERM = false, HAS_MID = false;
    const float* xin; float* out;
    __device__ __forceinline__ void operator()(const f32x4 (&acc)[2][2][4][2], const UnitX& u, int wr, int wc, int fr, int fq) const {
        asm volatile("" : "+v"(fr), "+v"(fq));
        const int row0 = u.pm * BM + wr * 64 + fr, col0 = u.pn * BM + wc * 32 + 4 * fq;
#pragma unroll
        for (int ai = 0; ai < 2; ++ai)
#pragma unroll
            for (int m = 0; m < 4; ++m) { const size_t off = (size_t)(row0 + ai * HALF + m * 16) * D + col0;
#pragma unroll
                for (int bj = 0; bj < 2; ++bj)
#pragma unroll
                    for (int n = 0; n < 2; ++n) { const f32x4 xv = *(const f32x4*)(xin + off + bj * HALF + n * 16); *(f32x4*)(out + off + bj * HALF + n * 16) = xv * DN_ALPHA + acc[ai][bj][m][n]; }
                if (m & 1) asm volatile("" ::: "memory"); }
    }
};

struct EpiSwiglu {
    static constexpr bool PERM = true, HAS_MID = false;
    bf16_t* h;
    __device__ __forceinline__ void operator()(const f32x4 (&acc)[2][2][4][2], const UnitX& u, int wr, int wc, int fr, int fq) const {
        asm volatile("" : "+v"(fr), "+v"(fq));
        const int row0 = u.pm * BM + wr * 64 + fr, col0 = u.pn * HALF + wc * 32 + 8 * fq;
#pragma unroll
        for (int ai = 0; ai < 2; ++ai)
#pragma unroll
            for (int m = 0; m < 4; ++m) { f32x4 o[2];
#pragma unroll
                for (int n = 0; n < 2; ++n)
#pragma unroll
                    for (int j = 0; j < 4; ++j) { const float a = acc[ai][0][m][n][j]; o[n][j] = a * __builtin_amdgcn_rcpf(1.0f + __builtin_amdgcn_exp2f(-LOG2E * a)) * acc[ai][1][m][n][j]; }
                u32x4 w; w.x = cvt_pk_bf16(o[0][0], o[0][1]); w.y = cvt_pk_bf16(o[0][2], o[0][3]); w.z = cvt_pk_bf16(o[1][0], o[1][1]); w.w = cvt_pk_bf16(o[1][2], o[1][3]);
                *(u32x4*)(h + (size_t)(row0 + ai * HALF + m * 16) * 512 + col0) = w; }
    }
};

struct EpiMoeOut {
    static constexpr bool PERM = true, HAS_MID = false;
    const unsigned* toks; const float* gl; const LAS int* cnt; bf16_t* o2;
    __device__ __forceinline__ void operator()(const f32x4 (&acc)[2][2][4][2], const UnitX& u, int wr, int wc, int fr, int fq) const {
        asm volatile("" : "+v"(fr), "+v"(fq));
        const int n_e = cnt[u.e], col0 = u.pn * BM + wc * 32 + 8 * fq;
        unsigned ents[2][4]; float gws[2][4];
#pragma unroll
        for (int ai = 0; ai < 2; ++ai)
#pragma unroll
            for (int m = 0; m < 4; ++m) { const int pos = u.blk * BM + ai * HALF + wr * 64 + m * 16 + fr; const bool ok = pos < n_e;
                ents[ai][m] = ok ? toks[(size_t)u.e * CAPE + pos] : 0u; gws[ai][m] = ok ? gl[(size_t)u.e * CAPE + pos] : 0.f; }
#pragma unroll
        for (int ai = 0; ai < 2; ++ai)
#pragma unroll
            for (int m = 0; m < 4; ++m) { const int pos = u.blk * BM + ai * HALF + wr * 64 + m * 16 + fr;
                if (pos < n_e) { const unsigned ent = ents[ai][m]; const float gw = gws[ai][m];
                    bf16_t* op = o2 + (size_t)ent * D + col0;
#pragma unroll
                    for (int bj = 0; bj < 2; ++bj) { const f32x4 v0 = acc[ai][bj][m][0] * gw, v1 = acc[ai][bj][m][1] * gw;
                        u32x4 w; w.x = cvt_pk_bf16(v0[0], v0[1]); w.y = cvt_pk_bf16(v0[2], v0[3]); w.z = cvt_pk_bf16(v1[0], v1[1]); w.w = cvt_pk_bf16(v1[2], v1[3]);
                        *(u32x4*)(op + bj * HALF) = w; } } }
    }
};
}
#define XB_TMO      128
#define XB_XCNT(j)  (256  + 64 * (j))
#define XB_XSUB(j)  (1280 + 64 * (j))
#define XB_XGEN(j)  (2304 + 64 * (j))
#define XB_TOP      3328
#define XB_TOPGEN   3392
#define XCD_BAR_WORDS 3456
#define XB_SPIN_CAP (1u << 18)

__device__ __forceinline__ unsigned xb_ld(unsigned* p)              { return __hip_atomic_load(p, __ATOMIC_RELAXED, __HIP_MEMORY_SCOPE_AGENT); }
__device__ __forceinline__ unsigned xb_add(unsigned* p, unsigned v) { return __hip_atomic_fetch_add(p, v, __ATOMIC_RELAXED, __HIP_MEMORY_SCOPE_AGENT); }
__device__ __forceinline__ unsigned xb_xcc_id() { return (unsigned)__builtin_amdgcn_s_getreg((3 << 11) | 20) & 0xFu; }
#define XB_SPIN(cond, bar) do { unsigned _sp = 0; while (cond) { __builtin_amdgcn_s_sleep(1); \
    if ((++_sp & 255u) == 0u) { if (xb_ld(&(bar)[XB_TMO])) break; if (_sp > XB_SPIN_CAP) { atomicAdd(&(bar)[XB_TMO], 1u); break; } } } } while (0)

struct XcdBarrier {
    unsigned* bar; unsigned x;
    volatile LAS unsigned* st;
    int w;
};

__device__ __forceinline__ XcdBarrier xcd_barrier_post(unsigned* bar, volatile LAS unsigned* st) {
    XcdBarrier b; b.bar = bar; b.x = xb_xcc_id(); b.st = st; b.w = (int)(threadIdx.x >> 6);
    if (threadIdx.x == 0) (void)xb_add(&bar[XB_XCNT(b.x)], 1u);
    return b;
}
__device__ __forceinline__ void xcd_barrier_complete(unsigned* bar, unsigned x, unsigned& nloc, unsigned& nx) {
    const unsigned G = gridDim.x * gridDim.y * gridDim.z;
    unsigned sum, cnt, mine, sp = 0u;
    for (;;) {
        sum = 0u; cnt = 0u; mine = 0u;
#pragma unroll
        for (unsigned j = 0; j < 16; ++j) { const unsigned c = xb_ld(&bar[XB_XCNT(j)]); sum += c; cnt += (c > 0u) ? 1u : 0u; mine = (j == x) ? c : mine; }
        if (sum == G) break;
        __builtin_amdgcn_s_sleep(1);
        if ((++sp & 255u) == 0u) { if (xb_ld(&bar[XB_TMO])) break; if (sp > XB_SPIN_CAP) { atomicAdd(&bar[XB_TMO], 1u); break; } }
    }
    nloc = mine > 0u ? mine : 1u; nx = cnt > 0u ? cnt : 1u;
}

__device__ __forceinline__ void xcd_barrier(const XcdBarrier& b) {
    asm volatile("s_waitcnt vmcnt(0)" ::: "memory");
    __syncthreads();
    if (b.w == 0 && gm::gm_lane_id() == 0) {
        unsigned* bar = b.bar;
        __builtin_amdgcn_s_waitcnt(0);
        unsigned nloc = b.st[0], nx = b.st[1];
        if (nloc == 0u) { xcd_barrier_complete(bar, b.x, nloc, nx); b.st[0] = nloc; b.st[1] = nx; }
        const unsigned old = xb_add(&bar[XB_XSUB(b.x)], 1u);
        const unsigned gen = old / nloc;
        if (old + 1u == (gen + 1u) * nloc) {
            __builtin_amdgcn_fence(__ATOMIC_RELEASE, "agent");
            asm volatile("s_waitcnt vmcnt(0)" ::: "memory");
            const unsigned og = xb_add(&bar[XB_TOP], 1u);
            const unsigned tg = og / nx;
            if (og + 1u == (tg + 1u) * nx) xb_add(&bar[XB_TOPGEN], 1u);
            else XB_SPIN(xb_ld(&bar[XB_TOPGEN]) == tg, bar);
            __builtin_amdgcn_fence(__ATOMIC_ACQUIRE, "agent");
            xb_add(&bar[XB_XGEN(b.x)], 1u);
            asm volatile("s_waitcnt vmcnt(0)" ::: "memory");
        } else {
            XB_SPIN(xb_ld(&bar[XB_XGEN(b.x)]) == gen, bar);
            __builtin_amdgcn_fence(__ATOMIC_ACQUIRE, "agent");
            asm volatile("s_waitcnt vmcnt(0)" ::: "memory");
        }
    }
    __syncthreads();
}

namespace ix {
typedef float f32x2 __attribute__((ext_vector_type(2)));
typedef __bf16 bf16v2 __attribute__((ext_vector_type(2)));
typedef short s16x2 __attribute__((ext_vector_type(2)));
__device__ __forceinline__ unsigned relu_pk_bf16(float a, float b) {
    const f32x2 v = {a, b}; const bf16v2 h = __builtin_convertvector(v, bf16v2);
    s16x2 s = __builtin_bit_cast(s16x2, h); const s16x2 z = {0, 0}; s = __builtin_elementwise_max(s, z);
    return __builtin_bit_cast(unsigned, s);
}
constexpr int CAP = 704, HI_WATER = 640, KEEP = 272, GT = 4, NK = CAP / 64;
constexpr int L_CAND = 0, L_IK = 32 * CAP * 4, L_IMG = L_IK, L_HIST = L_IK + 2 * GT * 8192, L_END = L_HIST + NWAVES * 512;
static_assert(L_END <= LDSCTL_OFF, "indexer LDS map");
__device__ __forceinline__ unsigned pack_key2(float s, unsigned idxpart) { const unsigned u = __float_as_uint(s); const unsigned m = (unsigned)((int)u >> 31) | 0x80000000u; return ((u ^ m) & 0xFFFFC000u) | idxpart; }
__device__ __forceinline__ unsigned pack_key(float s, int keyidx) { unsigned u = __float_as_uint(s); u = (u & 0x80000000u) ? ~u : (u | 0x80000000u); return (u & 0xFFFFC000u) | (unsigned)(16383 - keyidx); }
__device__ __forceinline__ int filter_keys(LAS unsigned* cq, int n, const unsigned (&k)[NK], unsigned T, int lane) {
    int base = 0;
#pragma unroll
    for (int j = 0; j < NK; ++j) { const bool keep = (lane + 64 * j < n) && (k[j] >= T); const unsigned long long bal = __ballot(keep);
        const int pos = base + (int)__builtin_amdgcn_mbcnt_hi((unsigned)(bal >> 32), __builtin_amdgcn_mbcnt_lo((unsigned)bal, 0u));
        if (keep) cq[pos] = k[j];
        base += __popcll(bal); }
    asm volatile("s_waitcnt lgkmcnt(0)" ::: "memory");
    return base;
}
__device__ __forceinline__ unsigned exact_threshold(const unsigned (&k)[NK], int n, LAS unsigned* hist, int lane) {
    unsigned prefix = 0u, T = 0u; int need = 256; bool done = false;
#pragma unroll 1
    for (int pass = 0; pass < 4 && !done; ++pass) {
        const int sh = 24 - 8 * pass;
        *(LAS unsigned long long*)(hist + 2 * lane) = 0ull;
        asm volatile("s_waitcnt lgkmcnt(0)" ::: "memory");
#pragma unroll
        for (int j = 0; j < NK; ++j) { const bool in = (lane + 64 * j < n) && ((pass == 0) || ((k[j] >> ((sh + 8) & 31)) == prefix)); const unsigned d_ = (k[j] >> sh) & 255u;
            if (in) __hip_atomic_fetch_add(hist + (d_ >> 1), (d_ & 1u) ? 0x10000u : 1u, __ATOMIC_RELAXED, __HIP_MEMORY_SCOPE_WORKGROUP); }
        asm volatile("s_waitcnt lgkmcnt(0)" ::: "memory");
        const unsigned long long cw_ = *(const LAS unsigned long long*)(hist + 2 * lane); v4u c; c.x = (unsigned)cw_ & 0xffffu; c.y = ((unsigned)cw_) >> 16; c.z = (unsigned)(cw_ >> 32) & 0xffffu; c.w = (unsigned)(cw_ >> 48);
        asm volatile("s_waitcnt lgkmcnt(0)" ::: "memory");
        const int s = (int)(c.x + c.y + c.z + c.w); int x = s;
#pragma unroll
        for (int o = 1; o < 64; o <<= 1) { const int y = __shfl_down(x, o); if (lane + o < 64) x += y; }
        const int above = x - s; const bool here = (above < need) && (x >= need);
        int b, ab, cb;
        { const int a3 = above, a2 = a3 + (int)c.w, a1 = a2 + (int)c.z, a0 = a1 + (int)c.y;
          if (a2 >= need) { b = 3; ab = a3; cb = (int)c.w; } else if (a1 >= need) { b = 2; ab = a2; cb = (int)c.z; } else if (a0 >= need) { b = 1; ab = a1; cb = (int)c.y; } else { b = 0; ab = a0; cb = (int)c.x; } }
        const unsigned long long hb = __ballot(here); const int src = hb ? (__ffsll((long long)hb) - 1) : 0;
        const int bg = __shfl(4 * lane + b, src); ab = __shfl(ab, src); cb = __shfl(cb, src);
        prefix = (prefix << 8) | (unsigned)bg; need -= ab; T = prefix << sh;
        if (cb == need) done = true;
    }
    return T;
}
__device__ __forceinline__ unsigned compact_keys(LAS unsigned* cq, int& n, bool final, LAS unsigned* hist, int lane) {
    unsigned k[NK];
#pragma unroll
    for (int j = 0; j < NK; ++j) { const int idx = lane + 64 * j; k[j] = (idx < n) ? cq[idx] : 0u; }
    unsigned T = 0u; bool exact = final;
    if (!final) {
        const int jj = lane % NK; unsigned smp = k[0];
#pragma unroll
        for (int j = 1; j < NK; ++j) smp = (jj == j) ? k[j] : smp;
        int rank = 0;
#pragma unroll
        for (int i = 0; i < 64; ++i) { const unsigned o = (unsigned)__builtin_amdgcn_readlane((int)smp, i); rank += (o > smp) ? 1 : 0; }
        int want = (64 * KEEP) / n, cnt = 0;
#pragma unroll 1
        for (int it = 0; it < 8; ++it) {
            const unsigned long long hb = __ballot(rank == want && smp != 0u);
            T = hb ? (unsigned)__builtin_amdgcn_readlane((int)smp, __ffsll((long long)hb) - 1) : 0u;
            cnt = 0;
#pragma unroll
            for (int j = 0; j < NK; ++j) cnt += __popcll(__ballot((lane + 64 * j < n) && (k[j] >= T)));
            if (cnt >= 256) break;
            want += 8; if (want > 63 || it == 6) { want = 64; }
        }
        exact = cnt > HI_WATER - 64;
    }
    if (exact) T = exact_threshold(k, n, hist, lane);
    n = filter_keys(cq, n, k, T, lane);
    return T;
}
__device__ __forceinline__ void indexer_unit(int g, const bf16* IQ, const bf16* IK, const float* IW, unsigned long long* MT, LAS unsigned char* lds, int tid, int lane, int wid, bool dry = false) {
    const int hi = lane >> 5, c31 = lane & 31;
    const int q0 = 32 * g, ntile = (g >> 1) + 1, ntimg = 4 * ((g >> 3) + 1), ngrp = (ntile + GT - 1) / GT;
    LAS unsigned* cand = (LAS unsigned*)(lds + L_CAND) + (4 * wid) * CAP;
    LAS unsigned* img = (LAS unsigned*)(lds + L_IMG);
    LAS unsigned* hist = (LAS unsigned*)(lds + L_HIST) + wid * 128;
    bf16x8 af[4]; { const bf16* ap = IQ + (size_t)(q0 + 4 * wid) * 512 + c31 * 64 + 8 * hi;
#pragma unroll
        for (int s = 0; s < 4; ++s) af[s] = *(const bf16x8*)(ap + 16 * s); }
    f32x4 wv[4];
#pragma unroll
    for (int ql = 0; ql < 4; ++ql) wv[ql] = *(const f32x4*)(IW + (size_t)(q0 + 4 * wid + ql) * 8 + 4 * hi);
    bf16x8 a2[2];
    { unsigned wh[4][2], wl[4][2];
#pragma unroll
        for (int ql = 0; ql < 4; ++ql) {
#pragma unroll
            for (int e = 0; e < 2; ++e) { const float x0 = wv[ql][2 * e], x1 = wv[ql][2 * e + 1]; const unsigned h0 = f2bf(x0), h1 = f2bf(x1);
                wh[ql][e] = h0 | (h1 << 16); wl[ql][e] = pk2(x0 - __uint_as_float(h0 << 16), x1 - __uint_as_float(h1 << 16)); } }
        const int m = c31; v4u u0 = {0u, 0u, 0u, 0u}, u1 = {0u, 0u, 0u, 0u};
        if (m == 0) { u0[0] = wh[0][0]; u0[1] = wh[0][1]; } if (m == 2) { u0[0] = wl[0][0]; u0[1] = wl[0][1]; }
        if (m == 1) { u0[2] = wh[1][0]; u0[3] = wh[1][1]; } if (m == 3) { u0[2] = wl[1][0]; u0[3] = wl[1][1]; }
        if (m == 4) { u1[0] = wh[2][0]; u1[1] = wh[2][1]; } if (m == 6) { u1[0] = wl[2][0]; u1[1] = wl[2][1]; }
        if (m == 5) { u1[2] = wh[3][0]; u1[3] = wh[3][1]; } if (m == 7) { u1[2] = wl[3][0]; u1[3] = wl[3][1]; }
        a2[0] = __builtin_bit_cast(bf16x8, u0); a2[1] = __builtin_bit_cast(bf16x8, u1); }
    int cnt0 = 0, cnt1 = 0, cnt2 = 0, cnt3 = 0; unsigned T0 = 0u, T1 = 0u, T2 = 0u, T3 = 0u;
    const GAS unsigned char* ikb = (const GAS unsigned char*)IK; const unsigned ikoff = (unsigned)tid * 16u;
    const unsigned stoff = (unsigned)((tid >> 3) * 128 + (((tid & 7) ^ ((tid >> 4) & 7)) * 16));
    v4u st[2];
#define IX_LD(TB) do { _Pragma("unroll") for (int i_ = 0; i_ < 2; ++i_) if ((TB) + i_ < ntile) st[i_] = *(const GAS v4u*)(ikb + (size_t)((TB) + i_) * 8192 + ikoff); } while (0)
#define IX_ST(TB, BUF, I0) do { _Pragma("unroll") for (int i_ = 0; i_ < 2; ++i_) if ((TB) + i_ < ntile) *(LAS v4u*)(lds + L_IK + (BUF) * (GT * 8192) + ((I0) + i_) * 8192 + stoff) = st[i_]; } while (0)
    IX_LD(0); IX_ST(0, 0, 0); IX_LD(2); IX_ST(2, 0, 2);
    __syncthreads();
    LAS unsigned* trash = hist + lane;
    const unsigned candb = (unsigned)__builtin_amdgcn_readfirstlane((int)(unsigned)(size_t)cand), trashb = (unsigned)(size_t)trash;
    const unsigned lidx = 16383u - (unsigned)lane;
    const LAS unsigned char* bbase = lds + L_IK + c31 * 128; const int sw = (c31 >> 1) & 7;
    int xo[4];
#pragma unroll
    for (int s = 0; s < 4; ++s) xo[s] = ((2 * s + hi) ^ sw) * 16;
    f32x16 dA0 = {}, dA1 = {}, dB0 = {}, dB1 = {};
#define IX_SB() __builtin_amdgcn_sched_barrier(0)
#define IX_MIX() do { if (IXMIXON) __builtin_amdgcn_sched_group_barrier(0x100, 8, 0); \
        _Pragma("unroll") for (int g_ = 0; g_ < 12; ++g_) if (IXMIXON) { __builtin_amdgcn_sched_group_barrier(0x008, 1, 0); __builtin_amdgcn_sched_group_barrier(0x006, 11, 0); } IX_SB(); } while (0)
#define IX_FR(TT, BUF, F) do { const LAS unsigned char* bt_ = bbase + (BUF) * (GT * 8192) + (TT) * 8192; \
        _Pragma("unroll") for (int s_ = 0; s_ < 4; ++s_) { F[s_] = *(const LAS bf16x8*)(bt_ + xo[s_]); F[4 + s_] = *(const LAS bf16x8*)(bt_ + 4096 + xo[s_]); } } while (0)
#define IX_MMA(F, D0, D1) do { _Pragma("unroll") for (int r_ = 0; r_ < 16; ++r_) { D0[r_] = 0.f; D1[r_] = 0.f; } \
        _Pragma("unroll") for (int s_ = 0; s_ < 4; ++s_) { D0 = __builtin_amdgcn_mfma_f32_32x32x16_bf16(af[s_], F[s_], D0, 0, 0, 0); D1 = __builtin_amdgcn_mfma_f32_32x32x16_bf16(af[s_], F[4 + s_], D1, 0, 0, 0); } } while (0)
#define IX_APPEND(SC, CNT, TQ, QI) do { const unsigned k32_ = pack_key2(SC, idxp_); const bool pass_ = k32_ >= (TQ); \
        const unsigned long long bal_ = __ballot(pass_); \
        unsigned sb_ = candb + 4u * (unsigned)((QI) * CAP + CNT); asm volatile("" : "+s"(sb_));     \
        const unsigned ad_ = sb_ + 4u * __builtin_amdgcn_mbcnt_hi((unsigned)(bal_ >> 32), __builtin_amdgcn_mbcnt_lo((unsigned)bal_, 0u)); \
        *(LAS unsigned*)(pass_ ? ad_ : trashb) = k32_;     \
        CNT += __popcll(bal_); } while (0)
#define IX_SUMS(D0, D1) do { sa0_ = D0[0] + D0[2]; sa1_ = D0[1] + D0[3]; sb0_ = D1[0] + D1[2]; sb1_ = D1[1] + D1[3]; } while (0)
#define IX_CVT1(D) do { v4u pa_, pb_; \
        _Pragma("unroll") for (int i_ = 0; i_ < 4; ++i_) { pa_[i_] = relu_pk_bf16(D[2 * i_], D[2 * i_ + 1]); pb_[i_] = relu_pk_bf16(D[8 + 2 * i_], D[9 + 2 * i_]); } \
        _Pragma("unroll") for (int r_ = 0; r_ < 16; ++r_) D[r_] = 0.f; \
        D = __builtin_amdgcn_mfma_f32_32x32x16_bf16(a2[0], __builtin_bit_cast(bf16x8, pa_), D, 0, 0, 0); D = __builtin_amdgcn_mfma_f32_32x32x16_bf16(a2[1], __builtin_bit_cast(bf16x8, pb_), D, 0, 0, 0); } while (0)
#define IX_CVT2(D0, D1) do { IX_CVT1(D0); IX_CVT1(D1); } while (0)
#define IX_APP(T) do { const bool ok_ = (unsigned)(T) < (unsigned)ntile; const unsigned idxp_ = lidx - 64u * (unsigned)(T);     \
        const auto r0_ = __builtin_amdgcn_permlane32_swap(__float_as_uint(sa0_), __float_as_uint(sb0_), false, false); \
        const auto r1_ = __builtin_amdgcn_permlane32_swap(__float_as_uint(sa1_), __float_as_uint(sb1_), false, false); \
        IX_APPEND(__uint_as_float(r0_[0]), cnt0, ok_ ? T0 : 0xFFFFFFFFu, 0); IX_APPEND(__uint_as_float(r1_[0]), cnt1, ok_ ? T1 : 0xFFFFFFFFu, 1); \
        IX_APPEND(__uint_as_float(r0_[1]), cnt2, ok_ ? T2 : 0xFFFFFFFFu, 2); IX_APPEND(__uint_as_float(r1_[1]), cnt3, ok_ ? T3 : 0xFFFFFFFFu, 3); } while (0)
#define IX_CUT(LIMIT, FINAL) do { asm volatile("" ::: "memory");     \
        _Pragma("unroll 1") for (;;) { const int q_ = (cnt0 > (LIMIT)) ? 0 : ((cnt1 > (LIMIT)) ? 1 : ((cnt2 > (LIMIT)) ? 2 : ((cnt3 > (LIMIT)) ? 3 : -1))); if (q_ < 0) break; \
            int n_ = (q_ == 0) ? cnt0 : ((q_ == 1) ? cnt1 : ((q_ == 2) ? cnt2 : cnt3)); const unsigned t_ = compact_keys(cand + q_ * CAP, n_, FINAL, hist, lane); \
            cnt0 = (q_ == 0) ? n_ : cnt0; cnt1 = (q_ == 1) ? n_ : cnt1; cnt2 = (q_ == 2) ? n_ : cnt2; cnt3 = (q_ == 3) ? n_ : cnt3; \
            const unsigned tu_ = (unsigned)__builtin_amdgcn_readfirstlane((int)t_); T0 = (q_ == 0) ? tu_ : T0; T1 = (q_ == 1) ? tu_ : T1; T2 = (q_ == 2) ? tu_ : T2; T3 = (q_ == 3) ? tu_ : T3; } } while (0)
#define IX_SLOT(U, X0, X1, Y0, Y1, FRNEXT) do { float sa0_, sa1_, sb0_, sb1_; IX_SUMS(X0, X1); IX_SB(); \
        IX_CVT2(Y0, Y1); IX_MMA(fA, X0, X1); FRNEXT; IX_APP((U) - 2); IX_MIX(); IX_CUT(HI_WATER, false); IX_SB(); } while (0)
    bf16x8 fA[8];
#pragma unroll 1
    for (int grp = 0; grp < ngrp; ++grp) {
        const int buf = grp & 1, t0 = grp * GT;
        IX_LD(t0 + GT);
        IX_FR(0, buf, fA); IX_SB();
        IX_SLOT(t0, dA0, dA1, dB0, dB1, IX_FR(1, buf, fA));
        IX_SLOT(t0 + 1, dB0, dB1, dA0, dA1, IX_FR(2, buf, fA));
        IX_ST(t0 + GT, buf ^ 1, 0); IX_LD(t0 + GT + 2);
        IX_SLOT(t0 + 2, dA0, dA1, dB0, dB1, IX_FR(3, buf, fA));
        IX_SLOT(t0 + 3, dB0, dB1, dA0, dA1, (void)0);
        IX_ST(t0 + GT + 2, buf ^ 1, 2);
        __syncthreads();
    }
    { const int u = ngrp * GT; float sa0_, sa1_, sb0_, sb1_;
      IX_SUMS(dA0, dA1); IX_SB(); IX_CVT2(dB0, dB1); IX_APP(u - 2); IX_SB(); IX_CUT(HI_WATER, false); IX_SB();
      IX_SUMS(dB0, dB1); IX_SB(); IX_APP(u - 1); IX_SB(); }
#undef IX_FR
#undef IX_LD
#undef IX_ST
#undef IX_SB
    if (dry) return;
    IX_CUT(256, true);
#undef IX_MMA
#undef IX_APPEND
#undef IX_SUMS
#undef IX_CVT2
#undef IX_CVT1
#undef IX_APP
#undef IX_SLOT
#undef IX_CUT
    v4u* dst = (v4u*)(MT + (size_t)g * 256 * 32);
#pragma unroll 1
    for (int qt = 0; qt * 64 < ntimg; ++qt) {
        for (int i = tid; i < 1024; i += NWAVES * 64) ((LAS v4u*)img)[i] = (v4u){0u, 0u, 0u, 0u};
        __syncthreads();
#pragma unroll
        for (int ql = 0; ql < 4; ++ql) { const int n = (ql == 0) ? cnt0 : ((ql == 1) ? cnt1 : ((ql == 2) ? cnt2 : cnt3));
            for (int idx = lane; idx < n; idx += 64) { const unsigned k32 = cand[ql * CAP + idx]; const int key = 16383 - (int)(k32 & 0x3FFFu), t = (key >> 6) - 64 * qt, kk = key & 63, c = kk & 31;
                if (t >= 0 && t < 64) { const int e = (c & 3) + 4 * (c >> 3) + 16 * (kk >> 5), dw = (t * 32 + e) * 2 + ((c >> 2) & 1);
                    __hip_atomic_fetch_or(img + dw, 1u << (4 * wid + ql), __ATOMIC_RELAXED, __HIP_MEMORY_SCOPE_WORKGROUP); } } }
        asm volatile("s_waitcnt lgkmcnt(0)" ::: "memory");
        __syncthreads();
        const int nq = (ntimg - 64 * qt < 64) ? (ntimg - 64 * qt) : 64;
        for (int i = tid; i < nq * 16; i += NWAVES * 64) dst[qt * 1024 + i] = ((const LAS v4u*)img)[i];
        __syncthreads();
    }
}
}

namespace ma {
constexpr int KROW = 272, VROW = 528, L_K = 0, L_V = 256 * KROW, L_WS = L_V + 128 * VROW, L_END = L_WS + NWAVES * 64 * 4;
__device__ __forceinline__ int crow(int r, int hi) { return (r & 3) + 8 * (r >> 2) + 4 * hi; }
__device__ __forceinline__ void mem_unit(int rowblk, int h, const bf16* mk, const bf16* mvt, const bf16* MQ, bf16* MO, LAS unsigned char* lds, int tid, int lane, int wid) {
    const int r32 = lane & 31, hi = lane >> 5;
#pragma unroll 1
    for (int h4 = 0; h4 < 2; ++h4) { v4u tk[4], tv[4];
#pragma unroll
        for (int k = 0; k < 4; ++k) { const int i = tid + 512 * (4 * h4 + k); tk[k] = *(const GAS v4u*)(mk + (size_t)(i >> 4) * 128 + (i & 15) * 8); tv[k] = *(const GAS v4u*)(mvt + (size_t)(i >> 5) * 256 + (i & 31) * 8); }
#pragma unroll
        for (int k = 0; k < 4; ++k) { const int i = tid + 512 * (4 * h4 + k); *(LAS v4u*)(lds + L_K + (i >> 4) * KROW + (i & 15) * 16) = tk[k]; *(LAS v4u*)(lds + L_V + (i >> 5) * VROW + (i & 31) * 16) = tv[k]; } }
    bf16x8 qr[8]; const bf16* qp = MQ + (size_t)(rowblk * 256 + 32 * wid + r32) * 512 + h * 128 + 8 * hi;
#pragma unroll
    for (int s = 0; s < 8; ++s) qr[s] = *(const bf16x8*)(qp + 16 * s);
    __syncthreads();
    LAS float* wsf = (LAS float*)(lds + L_WS) + wid * 64;
    float mrun = -1e30f, lrun = 0.f; f32x16 o[4];
#pragma unroll
    for (int db = 0; db < 4; ++db)
#pragma unroll
        for (int r = 0; r < 16; ++r) o[db][r] = 0.f;
#pragma unroll 1
    for (int jt = 0; jt < 4; ++jt) {
        f32x16 p0, p1;
#pragma unroll
        for (int r = 0; r < 16; ++r) { p0[r] = 0.f; p1[r] = 0.f; }
        const LAS unsigned char* kb = lds + L_K + (64 * jt + r32) * KROW + 16 * hi;
#pragma unroll
        for (int s = 0; s < 8; ++s) { const bf16x8 k0 = *(const LAS bf16x8*)(kb + 32 * s), k1 = *(const LAS bf16x8*)(kb + 32 * KROW + 32 * s);
            p0 = __builtin_amdgcn_mfma_f32_32x32x16_bf16(k0, qr[s], p0, 0, 0, 0); p1 = __builtin_amdgcn_mfma_f32_32x32x16_bf16(k1, qr[s], p1, 0, 0, 0); }
        float rm = fmaxf(p0[0], p1[0]);
#pragma unroll
        for (int r = 1; r < 16; ++r) rm = fmaxf(rm, fmaxf(p0[r], p1[r]));
        { const auto rr = __builtin_amdgcn_permlane32_swap(__float_as_uint(rm), __float_as_uint(rm), false, false); rm = fmaxf(__uint_as_float(rr[0]), __uint_as_float(rr[1])); }
        const float mn = fmaxf(mrun, rm), f = __builtin_amdgcn_exp2f(mrun - mn); mrun = mn;
        float ls = 0.f;
#pragma unroll
        for (int r = 0; r < 16; ++r) { p0[r] = __builtin_amdgcn_exp2f(p0[r] - mn); p1[r] = __builtin_amdgcn_exp2f(p1[r] - mn); ls += p0[r] + p1[r]; }
        lrun = lrun * f + ls;
        if (hi == 0) wsf[r32] = f;
        asm volatile("s_waitcnt lgkmcnt(0)" ::: "memory");
        float fr[16];
#pragma unroll
        for (int r = 0; r < 16; ++r) fr[r] = wsf[crow(r, hi)];
        asm volatile("s_waitcnt lgkmcnt(0)" ::: "memory");
#pragma unroll
        for (int db = 0; db < 4; ++db)
#pragma unroll
            for (int r = 0; r < 16; ++r) o[db][r] *= fr[r];
        bf16x8 pa[4];
        { v4u w;
          w.x = gm::cvt_pk_bf16(p0[0], p0[1]); w.y = gm::cvt_pk_bf16(p0[2], p0[3]); w.z = gm::cvt_pk_bf16(p0[4], p0[5]); w.w = gm::cvt_pk_bf16(p0[6], p0[7]); pa[0] = __builtin_bit_cast(bf16x8, w);
          w.x = gm::cvt_pk_bf16(p0[8], p0[9]); w.y = gm::cvt_pk_bf16(p0[10], p0[11]); w.z = gm::cvt_pk_bf16(p0[12], p0[13]); w.w = gm::cvt_pk_bf16(p0[14], p0[15]); pa[1] = __builtin_bit_cast(bf16x8, w);
          w.x = gm::cvt_pk_bf16(p1[0], p1[1]); w.y = gm::cvt_pk_bf16(p1[2], p1[3]); w.z = gm::cvt_pk_bf16(p1[4], p1[5]); w.w = gm::cvt_pk_bf16(p1[6], p1[7]); pa[2] = __builtin_bit_cast(bf16x8, w);
          w.x = gm::cvt_pk_bf16(p1[8], p1[9]); w.y = gm::cvt_pk_bf16(p1[10], p1[11]); w.z = gm::cvt_pk_bf16(p1[12], p1[13]); w.w = gm::cvt_pk_bf16(p1[14], p1[15]); pa[3] = __builtin_bit_cast(bf16x8, w); }
#pragma unroll
        for (int db = 0; db < 4; ++db) { const LAS unsigned char* vb = lds + L_V + (32 * db + r32) * VROW + (64 * jt + 8 * hi) * 2;
#pragma unroll
            for (int ks = 0; ks < 4; ++ks) { const bf16x8 vf = *(const LAS bf16x8*)(vb + 32 * ks); o[db] = __builtin_amdgcn_mfma_f32_32x32x16_bf16(pa[ks], vf, o[db], 0, 0, 0); } }
    }
    { const auto rr = __builtin_amdgcn_permlane32_swap(__float_as_uint(lrun), __float_as_uint(lrun), false, false); lrun = __uint_as_float(rr[0]) + __uint_as_float(rr[1]); }
    if (hi == 0) wsf[32 + r32] = __builtin_amdgcn_rcpf(lrun);
    asm volatile("s_waitcnt lgkmcnt(0)" ::: "memory");
    bf16* ob = MO + (size_t)(rowblk * 256 + 32 * wid) * 512 + h * 128 + r32;
#pragma unroll
    for (int r = 0; r < 16; ++r) { const int qrow = crow(r, hi); const float rl = wsf[32 + qrow];
#pragma unroll
        for (int db = 0; db < 4; ++db) ob[(size_t)qrow * 512 + 32 * db] = (bf16)f2bf(o[db][r] * rl); }
    asm volatile("s_waitcnt lgkmcnt(0)" ::: "memory");
    __syncthreads();
}
}

struct Args { const float* in[19]; float* out; unsigned char* ws; };
struct Ctx { LAS unsigned char* lds; volatile LAS unsigned* MISC; GAS unsigned* ctl; int tid, lane, wave, vcu, G; };

__device__ __forceinline__ void transpose_item(const float* W, int ldw, int mode, int c0, bf16* WT, int ldt, int kcol0, int k0, int n0, LAS float* scr, int lane) {
    const int j = lane & 31, sc = (mode == 1) ? in_src_col(n0 + j) : c0 + j;
    const GAS float* wp_ = (const GAS float*)W + (size_t)(k0 + (lane >> 5)) * ldw + (sc >= 0 ? sc : 0);
#pragma unroll 1
    for (int h = 0; h < 2; ++h) { float t_[16];
#pragma unroll
        for (int i = 0; i < 16; ++i) t_[i] = wp_[(size_t)(2 * (16 * h + i)) * ldw];
#pragma unroll
        for (int i = 0; i < 16; ++i) scr[(2 * (16 * h + i) + (lane >> 5)) * 33 + j] = (sc >= 0) ? t_[i] : 0.f; }
    LDS_WAIT(); asm volatile("" ::: "memory");
    const int c = lane & 7;
#pragma unroll
    for (int jj = 0; jj < 4; ++jj) { const int n = (lane >> 3) + 8 * jj; const LAS float* s = scr + (8 * c) * 33 + n;
        v4u o; o.x = pk2(s[0 * 33], s[1 * 33]); o.y = pk2(s[2 * 33], s[3 * 33]); o.z = pk2(s[4 * 33], s[5 * 33]); o.w = pk2(s[6 * 33], s[7 * 33]);
        *(GAS v4u*)(WT + (size_t)(n0 + n) * ldt + kcol0 + k0 + 8 * c) = o; }
    LDS_WAIT(); asm volatile("" ::: "memory");
}
#define T_VARS(X) const GAS float* wp##X = nullptr; size_t ld##X = 0; int ok##X = 0; bf16* WT##X = nullptr; int lt##X = 0, kc##X = 0, nn##X = 0
#define T_SET(X, W, LDW, MODE, C0, WT_, LDT, KCOL0, K0, N0) do { const int nq_ = lane & 7, kq_ = lane >> 3, sc_ = ((MODE) == 1) ? in_src_col((N0) + 4 * nq_) : (C0) + 4 * nq_; \
        ok##X = sc_ >= 0; ld##X = (size_t)(LDW); wp##X = (const GAS float*)(W) + (size_t)((K0) + kq_) * (LDW) + (ok##X ? sc_ : 0); WT##X = (WT_); lt##X = (LDT); kc##X = (KCOL0) + (K0); nn##X = (N0); } while (0)
#define T_LOAD(B, X) do { _Pragma("unroll") for (int r_ = 0; r_ < 8; ++r_) B[r_] = *(const GAS f32x4*)(wp##X + (size_t)(8 * r_) * ld##X); } while (0)
__device__ __forceinline__ void t_finish(const f32x4 (&B)[8], int ok, bf16* WT, int ldt, int kc, int n0, LAS float* scr, int lane) {
    const int nq = lane & 7, kq = lane >> 3;
#pragma unroll
    for (int r = 0; r < 8; ++r) { LAS float* d = scr + (8 * r + kq) * 33 + 4 * nq; const f32x4 v = ok ? B[r] : (f32x4){0.f, 0.f, 0.f, 0.f}; d[0] = v.x; d[1] = v.y; d[2] = v.z; d[3] = v.w; }
    LDS_WAIT(); asm volatile("" ::: "memory");
    const int c = lane & 7;
#pragma unroll
    for (int jj = 0; jj < 4; ++jj) { const int n = (lane >> 3) + 8 * jj; const LAS float* sp = scr + (8 * c) * 33 + n;
        v4u o; o.x = pk2(sp[0 * 33], sp[1 * 33]); o.y = pk2(sp[2 * 33], sp[3 * 33]); o.z = pk2(sp[4 * 33], sp[5 * 33]); o.w = pk2(sp[6 * 33], sp[7 * 33]);
        *(GAS v4u*)(WT + (size_t)(n0 + n) * ldt + kc + 8 * c) = o; }
    LDS_WAIT(); asm volatile("" ::: "memory");
}
#define T_RUN(DECODE, IT0, ITEND, STEP) do { int it_ = (IT0); if (it_ < (ITEND)) { f32x4 bA_[8], bB_[8]; T_VARS(A); T_VARS(B); \
        DECODE(it_, A); T_LOAD(bA_, A); \
        _Pragma("unroll 1") for (;;) { \
            const int it2_ = it_ + (STEP); const bool has2_ = it2_ < (ITEND); \
            if (has2_) { DECODE(it2_, B); T_LOAD(bB_, B); } \
            t_finish(bA_, okA, WTA, ltA, kcA, nnA, scr, lane); \
            if (!has2_) break; \
            const int it3_ = it2_ + (STEP); const bool has3_ = it3_ < (ITEND); \
            if (has3_) { DECODE(it3_, A); T_LOAD(bA_, A); } \
            t_finish(bB_, okB, WTB, ltB, kcB, nnB, scr, lane); \
            if (!has3_) break; \
            it_ = it3_; } } } while (0)
__device__ __forceinline__ void sincos_d(double a, float& sn, float& cs) {
    const double q = rint(a * 0.63661977236758134308); const double r = fma(-q, 1.57079632679489655800, a) - q * 6.12323399573676603587e-17; const int qi = ((int)q) & 3;
    const double r2 = r * r;
    const double s = r * (1.0 + r2 * (-1.0 / 6 + r2 * (1.0 / 120 + r2 * (-1.0 / 5040 + r2 * (1.0 / 362880 + r2 * (-1.0 / 39916800 + r2 * (1.0 / 6227020800.0)))))));
    const double c = 1.0 + r2 * (-0.5 + r2 * (1.0 / 24 + r2 * (-1.0 / 720 + r2 * (1.0 / 40320 + r2 * (-1.0 / 3628800 + r2 * (1.0 / 479001600.0 + r2 * (-1.0 / 87178291200.0)))))));
    const double ss = (qi == 0) ? s : ((qi == 1) ? c : ((qi == 2) ? -s : -c)), cc = (qi == 0) ? c : ((qi == 1) ? -s : ((qi == 2) ? -c : s));
    sn = (float)ss; cs = (float)cc;
}
__device__ __forceinline__ void p0_prologue(const Args& a, const Ctx& F) {
    unsigned char* ws = a.ws;
    const int gw = F.vcu * NWAVES + F.wave, NGW = F.G * NWAVES, lane = F.lane;
    LAS float* scr = (LAS float*)(F.lds + F.wave * 16384);
#ifndef P0SUB
#define P0SUB 0
#endif
    { const size_t gt0 = (size_t)F.vcu * (NWAVES * 64) + F.tid;
      if (gt0 < 256 * D / 8) { const f32x4 v0 = ((const GAS f32x4*)a.in[1])[2 * gt0], v1 = ((const GAS f32x4*)a.in[1])[2 * gt0 + 1];
          v4u o; o.x = pk2(v0.x, v0.y); o.y = pk2(v0.z, v0.w); o.z = pk2(v1.x, v1.y); o.w = pk2(v1.z, v1.w); ((GAS v4u*)(ws + WS_MEMB))[gt0] = o; } }
    for (int it = gw; it < NL * 4 * 16 * 16; it += NGW) { const int l = it >> 10, g = (it >> 8) & 3, db = (it >> 4) & 15, cb = it & 15, d = db * 64 + lane;
        const float* pw = a.in[5] + ((size_t)(l * 4 + g) * 128 + cb * 8) * 128; const float* ps = a.in[6] + (size_t)l * 512 + g * 128; const float* wb = a.in[8] + (size_t)l * 3 * 512 * D + (size_t)g * 128 * D + d;
        float acc[8];
#pragma unroll
        for (int i = 0; i < 8; ++i) acc[i] = 0.f;
#pragma unroll 1
        for (int e0 = 0; e0 < 128; e0 += 16) { float w[16];
#pragma unroll
            for (int ee = 0; ee < 16; ++ee) w[ee] = ((const GAS float*)wb)[(size_t)(e0 + ee) * D];
#pragma unroll
            for (int ee = 0; ee < 16; ++ee) { const float ws_ = w[ee] * ps[e0 + ee];
#pragma unroll
                for (int i = 0; i < 8; ++i) acc[i] = fmaf(pw[(size_t)i * 128 + e0 + ee], ws_, acc[i]); } }
        v4u o; o.x = pk2(acc[0], acc[1]); o.y = pk2(acc[2], acc[3]); o.z = pk2(acc[4], acc[5]); o.w = pk2(acc[6], acc[7]);
        *(GAS v4u*)((bf16*)(ws + WS_WBR + (size_t)l * WBR_BYTES) + (size_t)d * 1536 + g * 128 + cb * 8) = o;
    }
    { constexpr int I_IN = 16 * (N1 / 32), I_BR = 8 * 32, I_OUT = 16 * 32, I_MEM = 16 * 32, PER_L = I_IN + 2 * I_BR + I_OUT + I_MEM;
      const float* win = a.in[3]; const float* wbr = a.in[8]; const float* wout = a.in[9]; const float* wmem = a.in[7];
#define DEC_DENSE(IT, X) do { const int l_ = (IT) / PER_L; int r_d = (IT) % PER_L; \
          if (r_d < I_IN) { const int kb = r_d / (N1 / 32), nb = r_d % (N1 / 32); T_SET(X, win + (size_t)l_ * D * DIN, DIN, 1, 0, (bf16*)(ws + WS_WIN + (size_t)l_ * WIN_BYTES), D, 0, 64 * kb, 32 * nb); } \
          else if (r_d < I_IN + 2 * I_BR) { r_d -= I_IN; const int n = 1 + r_d / I_BR, rr = r_d % I_BR, kb = rr / 32, nb = rr % 32; \
              T_SET(X, wbr + ((size_t)l_ * 3 + n) * 512 * D, D, 0, 32 * nb, (bf16*)(ws + WS_WBR + (size_t)l_ * WBR_BYTES), 1536, 512 * n, 64 * kb, 32 * nb); } \
          else if (r_d < I_IN + 2 * I_BR + I_OUT) { r_d -= I_IN + 2 * I_BR; const int kb = r_d / 32, nb = r_d % 32; T_SET(X, wout + (size_t)l_ * D * D, D, 0, 32 * nb, (bf16*)(ws + WS_WOUT + (size_t)l_ * WOUT_BYTES), D, 0, 64 * kb, 32 * nb); } \
          else { r_d -= I_IN + 2 * I_BR + I_OUT; const int kb = r_d / 32, nb = r_d % 32; T_SET(X, wmem + (size_t)l_ * D * 1024, 1024, 0, 32 * nb, (bf16*)(ws + WS_WMEM) + (size_t)l_ * 1024 * D, D, 0, 64 * kb, 32 * nb); } } while (0)
      for (int repc_ = 0; repc_ < ((P0SUB == 2) ? 2 : 1); ++repc_) T_RUN(DEC_DENSE, gw, NL * PER_L, NGW);
#undef DEC_DENSE
    }
    const size_t gt = (size_t)F.vcu * (NWAVES * 64) + F.tid, NGT = (size_t)F.G * NWAVES * 64;
    for (size_t i = gt; i < (size_t)NL * N1; i += NGT) { const int l = (int)(i / N1), j = (int)(i % N1), sc = in_src_col(j); ((float*)(ws + WS_BIAS))[i] = (sc >= 0) ? a.in[4][(size_t)l * DIN + sc] : 0.f; }
    const float invf = powf(10000.0f, -(float)(int)(gt & 31) * (1.0f / 32.0f));
    static_assert((NWAVES * 64) % 32 == 0, "rotary table: one frequency per thread");
    for (int repr_ = 0; repr_ < ((P0SUB == 4) ? 2 : 1); ++repr_)
    for (size_t i = gt; i < (size_t)S * 32; i += NGT) { const int t = (int)(i >> 5);
        const float ang = (float)((const int*)a.in[2])[t] * invf;
        float sn, cs; sincos_d((double)ang, sn, cs); ((float*)(ws + WS_RCOS))[i] = cs; ((float*)(ws + WS_RSIN))[i] = sn; }
    for (int repd_ = 0; repd_ < ((P0SUB == 3) ? 2 : 1); ++repd_)
#pragma unroll 1
    for (size_t i = gt; i < (size_t)S * D / 8; i += 4 * NGT) { f32x4 v[8];
#pragma unroll
        for (int u = 0; u < 4; ++u) { const size_t j = (i + u * NGT < (size_t)S * D / 8) ? i + u * NGT : i; v[2 * u] = ((const GAS f32x4*)a.in[0])[2 * j]; v[2 * u + 1] = ((const GAS f32x4*)a.in[0])[2 * j + 1]; }
#pragma unroll
        for (int u = 0; u < 4; ++u) if (i + u * NGT < (size_t)S * D / 8) { const f32x4 v0 = v[2 * u], v1 = v[2 * u + 1];
            v4u o; o.x = pk2(v0.x, v0.y); o.y = pk2(v0.z, v0.w); o.z = pk2(v1.x, v1.y); o.w = pk2(v1.z, v1.w); ((GAS v4u*)(ws + WS_XB))[i + u * NGT] = o; } }
}
__device__ __forceinline__ void pool_diff(const bf16* PU, bf16* PD, const Ctx& F) {
    const size_t gt = (size_t)F.vcu * (NWAVES * 64) + F.tid, NGT = (size_t)F.G * NWAVES * 64;
    for (size_t i = gt; i < (size_t)S * 64; i += NGT) { const int t = (int)(i >> 6), ch = (int)(i & 63), w = 2 << (ch >> 4), cntw = (t + 1 < w) ? t + 1 : w;
        const GAS v4u* p = (const GAS v4u*)(PU + (size_t)t * 512 + ch * 8);
        const v4u u0 = p[0]; float s[8] = {gm::bf_lo(u0.x), gm::bf_hi(u0.x), gm::bf_lo(u0.y), gm::bf_hi(u0.y), gm::bf_lo(u0.z), gm::bf_hi(u0.z), gm::bf_lo(u0.w), gm::bf_hi(u0.w)};
        float self[8];
#pragma unroll
        for (int k = 0; k < 8; ++k) self[k] = s[k];
        v4u vv[15];
#pragma unroll
        for (int j = 1; j < 16; ++j) vv[j - 1] = (j < cntw) ? *(p - (size_t)j * 64) : (v4u){0u, 0u, 0u, 0u};
#pragma unroll
        for (int j = 1; j < 16; ++j) { const v4u v = vv[j - 1];
            s[0] += gm::bf_lo(v.x); s[1] += gm::bf_hi(v.x); s[2] += gm::bf_lo(v.y); s[3] += gm::bf_hi(v.y); s[4] += gm::bf_lo(v.z); s[5] += gm::bf_hi(v.z); s[6] += gm::bf_lo(v.w); s[7] += gm::bf_hi(v.w); }
        const float inv = 1.0f / (float)cntw;
        v4u o; o.x = pk2(s[0] * inv - self[0], s[1] * inv - self[1]); o.y = pk2(s[2] * inv - self[2], s[3] * inv - self[3]); o.z = pk2(s[4] * inv - self[4], s[5] * inv - self[5]); o.w = pk2(s[6] * inv - self[6], s[7] * inv - self[7]);
        *(GAS v4u*)(PD + (size_t)t * 512 + ch * 8) = o; }
}
__device__ __forceinline__ void ln1_route(const float* X, float* XO, bool lists, bf16* XB, const float* g1, const float* b1, const float* wrt, const float* rbias, unsigned* toks, float* gl, GAS unsigned* ecnt, const Ctx& F) {
    LAS float* wl = (LAS float*)F.lds;
    LAS int* sel = (LAS int*)(F.lds + 65536);
    LAS float* selw = (LAS float*)(F.lds + 65536 + 1024);
    LAS unsigned* lcnt = (LAS unsigned*)(F.lds + 65536 + 2048);
    { f32x4 wq[8];
#pragma unroll
      for (int k = 0; k < 8; ++k) wq[k] = ((const GAS f32x4*)wrt)[F.tid + 512 * k];
#pragma unroll
      for (int k = 0; k < 8; ++k) { const int i4 = F.tid + 512 * k, c = i4 >> 2, e0 = (i4 & 3) * 4; wl[(e0 + 0) * D + c] = wq[k].x; wl[(e0 + 1) * D + c] = wq[k].y; wl[(e0 + 2) * D + c] = wq[k].z; wl[(e0 + 3) * D + c] = wq[k].w; } }
    if (F.tid < 32) lcnt[F.tid] = 0u;
    __syncthreads();
    const int lane = F.lane;
    for (int rb = F.vcu; rb < S / 64; rb += F.G) {
        f32x4 vn[4];
        { const GAS f32x4* x0 = (const GAS f32x4*)(X + (size_t)(rb * 64 + F.wave * 8) * D) + lane;
#pragma unroll
          for (int j = 0; j < 4; ++j) vn[j] = x0[64 * j]; }
#pragma unroll 1
        for (int rr = 0; rr < 8; ++rr) { const int rl = F.wave * 8 + rr, row = rb * 64 + rl;
            GAS f32x4* xo = (GAS f32x4*)(XO + (size_t)row * D) + lane;
            f32x4 v[4]; float s = 0.f;
#pragma unroll
            for (int j = 0; j < 4; ++j) { v[j] = vn[j]; s += (v[j].x + v[j].y) + (v[j].z + v[j].w); }
            { const GAS f32x4* x1 = (const GAS f32x4*)(X + (size_t)(row + (rr < 7 ? 1 : 0)) * D) + lane;
#pragma unroll
              for (int j = 0; j < 4; ++j) vn[j] = x1[64 * j]; }
            const float mean = wave_sum(s) * (1.f / D); float s2 = 0.f;
#pragma unroll
            for (int j = 0; j < 4; ++j) { v[j] = v[j] - mean; s2 += (v[j].x * v[j].x + v[j].y * v[j].y) + (v[j].z * v[j].z + v[j].w * v[j].w); }
            const float rstd = 1.f / sqrtf(wave_sum(s2) * (1.f / D) + LN_EPS);
            GAS unsigned long long* o8 = (GAS unsigned long long*)(XB + (size_t)row * D) + lane;
#pragma unroll
            for (int j = 0; j < 4; ++j) { const f32x4 gg = ((const GAS f32x4*)g1)[64 * j + lane], bb = ((const GAS f32x4*)b1)[64 * j + lane]; v[j] = v[j] * rstd * gg + bb; xo[64 * j] = v[j];
                o8[64 * j] = (unsigned long long)pk2(v[j].x, v[j].y) | ((unsigned long long)pk2(v[j].z, v[j].w) << 32); }
            float pl[NEXP];
#pragma unroll
            for (int e = 0; e < NEXP; ++e) { float p = 0.f;
#pragma unroll
                for (int j = 0; j < 4; ++j) { const f32x4 w = *(const LAS f32x4*)(wl + e * D + 256 * j + 4 * lane); p += (v[j].x * w.x + v[j].y * w.y) + (v[j].z * w.z + v[j].w * w.w); }
                pl[e] = p; }
            float r8[8], r4[4], r2[2], r1;
#pragma unroll
            for (int i = 0; i < 8; ++i) { const bool up = (lane & 32) != 0; const float mine = up ? pl[8 + i] : pl[i], send = up ? pl[i] : pl[8 + i]; r8[i] = mine + __shfl_xor(send, 32); }
#pragma unroll
            for (int i = 0; i < 4; ++i) { const bool up = (lane & 16) != 0; const float mine = up ? r8[4 + i] : r8[i], send = up ? r8[i] : r8[4 + i]; r4[i] = mine + __shfl_xor(send, 16); }
#pragma unroll
            for (int i = 0; i < 2; ++i) { const bool up = (lane & 8) != 0; const float mine = up ? r4[2 + i] : r4[i], send = up ? r4[i] : r4[2 + i]; r2[i] = mine + __shfl_xor(send, 8); }
            { const bool up = (lane & 4) != 0; const float mine = up ? r2[1] : r2[0], send = up ? r2[0] : r2[1]; r1 = mine + __shfl_xor(send, 4); }
            r1 += __shfl_xor(r1, 2); r1 += __shfl_xor(r1, 1);
            const float sg1 = 1.0f / (1.0f + expf(-r1));
            float sc[NEXP], bs[NEXP];
#pragma unroll
            for (int e = 0; e < NEXP; ++e) { sc[e] = __builtin_bit_cast(float, __builtin_amdgcn_readlane(__builtin_bit_cast(int, sg1), ((e >> 3) & 1) * 32 + ((e >> 2) & 1) * 16 + ((e >> 1) & 1) * 8 + (e & 1) * 4)); bs[e] = sc[e] + rbias[e]; }
            float gs[4];
#pragma unroll
            for (int g = 0; g < 4; ++g) { const float a_ = fmaxf(bs[4 * g], bs[4 * g + 1]), b_ = fminf(bs[4 * g], bs[4 * g + 1]), c_ = fmaxf(bs[4 * g + 2], bs[4 * g + 3]), d_ = fminf(bs[4 * g + 2], bs[4 * g + 3]);
                gs[g] = fmaxf(a_, c_) + fmaxf(fminf(a_, c_), fmaxf(b_, d_)); }
            int best = 0; float bg = gs[0];
#pragma unroll
            for (int g = 1; g < 4; ++g) if (gs[g] > bg) { bg = gs[g]; best = g; }
            float wb[4], ws_[4];
#pragma unroll
            for (int i = 0; i < 4; ++i) { wb[i] = (best == 0) ? bs[i] : ((best == 1) ? bs[4 + i] : ((best == 2) ? bs[8 + i] : bs[12 + i])); ws_[i] = (best == 0) ? sc[i] : ((best == 1) ? sc[4 + i] : ((best == 2) ? sc[8 + i] : sc[12 + i])); }
            int i1 = 0; float m1 = wb[0];
#pragma unroll
            for (int i = 1; i < 4; ++i) if (wb[i] > m1) { m1 = wb[i]; i1 = i; }
            int i2 = -1; float m2 = 0.f;
#pragma unroll
            for (int i = 0; i < 4; ++i) if (i != i1 && (i2 < 0 || wb[i] > m2)) { m2 = wb[i]; i2 = i; }
            const float w1 = (i1 == 0) ? ws_[0] : ((i1 == 1) ? ws_[1] : ((i1 == 2) ? ws_[2] : ws_[3])), w2 = (i2 == 0) ? ws_[0] : ((i2 == 1) ? ws_[1] : ((i2 == 2) ? ws_[2] : ws_[3]));
            const float wsum = w1 + w2;
            if (lane == 0) { const int e0 = 4 * best + i1, e1 = 4 * best + i2;
                sel[rl * 4 + 0] = e0; sel[rl * 4 + 1] = e1;
                sel[rl * 4 + 2] = (int)__hip_atomic_fetch_add(lcnt + e0, 1u, __ATOMIC_RELAXED, __HIP_MEMORY_SCOPE_WORKGROUP);
                sel[rl * 4 + 3] = (int)__hip_atomic_fetch_add(lcnt + e1, 1u, __ATOMIC_RELAXED, __HIP_MEMORY_SCOPE_WORKGROUP);
                selw[rl * 2 + 0] = w1 / wsum; selw[rl * 2 + 1] = w2 / wsum; }
        }
        LDS_WAIT(); __syncthreads();
        if (F.tid < NEXP && lists) lcnt[16 + F.tid] = __hip_atomic_fetch_add(ecnt + 64 * F.tid, lcnt[F.tid], __ATOMIC_RELAXED, __HIP_MEMORY_SCOPE_AGENT);
        LDS_WAIT(); __syncthreads();
        if (F.tid < 128 && lists) { const int rl = F.tid >> 1, k = F.tid & 1, e = sel[rl * 4 + k]; const unsigned pos = lcnt[16 + e] + (unsigned)sel[rl * 4 + 2 + k];
            toks[(size_t)e * CAPE + pos] = (unsigned)((rb * 64 + rl) * 2 + k); gl[(size_t)e * CAPE + pos] = selw[rl * 2 + k]; }
        LDS_WAIT(); __syncthreads();
        if (F.tid < 32) lcnt[F.tid] = 0u;
        LDS_WAIT(); __syncthreads();
    }
}
__device__ __forceinline__ void moe_weights(const float* w1, const float* w3, const float* w2, bf16* W13, bf16* W2T, const Ctx& F) {
    const int gw = F.vcu * NWAVES + F.wave, NGW = F.G * NWAVES; LAS float* scr = (LAS float*)(F.lds + 69632 + F.wave * 8704);
    constexpr int I13 = 16 * 32, I2 = 8 * 32;
    const int lane = F.lane;
#define DEC_MOE(IT, X) do { const int e_ = (IT) / (I13 + I2); int r_m = (IT) % (I13 + I2); \
        if (r_m < I13) { const int kb = r_m >> 5, nb = r_m & 31, n0 = 32 * nb, rr = n0 & 255, pn = n0 >> 8; const size_t wo_ = (size_t)e_ * D * DEXP; \
            if (rr < 128) T_SET(X, w1 + wo_, DEXP, 0, pn * 128 + (rr & 127), W13 + (size_t)e_ * 1024 * 1024, 1024, 0, 64 * kb, n0); else T_SET(X, w3 + wo_, DEXP, 0, pn * 128 + (rr & 127), W13 + (size_t)e_ * 1024 * 1024, 1024, 0, 64 * kb, n0); } \
        else { r_m -= I13; const int kb = r_m >> 5, nb = r_m & 31; T_SET(X, w2 + (size_t)e_ * DEXP * D, D, 0, 32 * nb, W2T + (size_t)e_ * 1024 * 512, 512, 0, 64 * kb, 32 * nb); } } while (0)
    T_RUN(DEC_MOE, gw, NEXP * (I13 + I2), NGW);
#undef DEC_MOE
}
__device__ __forceinline__ void ln2_rows(const float* X, float* XO, const bf16* O2, bf16* XB, const float* g2, const float* b2, const Ctx& F) {
    const int gw = F.vcu * NWAVES + F.wave, NGW = F.G * NWAVES, lane = F.lane;
    f32x4 xn[4]; unsigned long long an[4], bn[4];
    if (gw < S) { const GAS f32x4* x0 = (const GAS f32x4*)(X + (size_t)gw * D) + lane; const GAS unsigned long long* o0 = (const GAS unsigned long long*)(O2 + (size_t)gw * 2 * D) + lane;
#pragma unroll
        for (int j = 0; j < 4; ++j) { xn[j] = x0[64 * j]; an[j] = o0[64 * j]; bn[j] = o0[256 + 64 * j]; } }
#pragma unroll 1
    for (int row = gw; row < S; row += NGW) {
        GAS f32x4* xo = (GAS f32x4*)(XO + (size_t)row * D) + lane;
        f32x4 xr[4]; unsigned long long oa[4], ob[4];
#pragma unroll
        for (int j = 0; j < 4; ++j) { xr[j] = xn[j]; oa[j] = an[j]; ob[j] = bn[j]; }
        { const int rn = (row + NGW < S) ? row + NGW : row; const GAS f32x4* x1 = (const GAS f32x4*)(X + (size_t)rn * D) + lane; const GAS unsigned long long* o1 = (const GAS unsigned long long*)(O2 + (size_t)rn * 2 * D) + lane;
#pragma unroll
          for (int j = 0; j < 4; ++j) { xn[j] = x1[64 * j]; an[j] = o1[64 * j]; bn[j] = o1[256 + 64 * j]; } }
        f32x4 v[4]; float s = 0.f;
#pragma unroll
        for (int j = 0; j < 4; ++j) { const unsigned long long a = oa[j], b = ob[j]; const unsigned a0 = (unsigned)a, a1 = (unsigned)(a >> 32), b0 = (unsigned)b, b1 = (unsigned)(b >> 32);
            v[j] = xr[j] * DN_ALPHA + ((f32x4){gm::bf_lo(a0), gm::bf_hi(a0), gm::bf_lo(a1), gm::bf_hi(a1)} + (f32x4){gm::bf_lo(b0), gm::bf_hi(b0), gm::bf_lo(b1), gm::bf_hi(b1)});
            s += (v[j].x + v[j].y) + (v[j].z + v[j].w); }
        const float mean = wave_sum(s) * (1.f / D); float s2 = 0.f;
#pragma unroll
        for (int j = 0; j < 4; ++j) { v[j] = v[j] - mean; s2 += (v[j].x * v[j].x + v[j].y * v[j].y) + (v[j].z * v[j].z + v[j].w * v[j].w); }
        const float rstd = 1.f / sqrtf(wave_sum(s2) * (1.f / D) + LN_EPS);
        GAS unsigned long long* o8 = (GAS unsigned long long*)(XB + (size_t)row * D) + lane;
#pragma unroll
        for (int j = 0; j < 4; ++j) { const f32x4 gg = ((const GAS f32x4*)g2)[64 * j + lane], bb = ((const GAS f32x4*)b2)[64 * j + lane]; v[j] = v[j] * rstd * gg + bb; xo[64 * j] = v[j];
            o8[64 * j] = (unsigned long long)pk2(v[j].x, v[j].y) | ((unsigned long long)pk2(v[j].z, v[j].w) << 32); }
    }
}

__global__ void __launch_bounds__(NWAVES * 64, 2) hybrid_fwd(Args args) {
    extern __shared__ __attribute__((aligned(16))) unsigned char lds[];
    Ctx F;
    F.lds = (LAS unsigned char*)lds; F.MISC = (volatile LAS unsigned*)(F.lds + LDSCTL_OFF);
    F.tid = threadIdx.x; F.lane = F.tid & 63; F.wave = __builtin_amdgcn_readfirstlane(F.tid >> 6);
    const int wave_s = F.wave;
    F.G = gridDim.x; { const int bx = blockIdx.x; F.vcu = (F.G % 8 == 0) ? (bx % 8) * (F.G / 8) + bx / 8 : bx; }
    const int vcu0 = F.vcu;
    unsigned char* ws = args.ws; F.ctl = (GAS unsigned*)(ws + WS_CTL);
    if (F.tid < 64) ((LAS unsigned*)(F.lds + LDSCTL_OFF))[F.tid] = 0u;
    __syncthreads();
    (void)xcd_barrier_post((unsigned*)(F.ctl + CW_BAR), F.MISC + 8);

#define GRID_BAR() do { XcdBarrier b_; unsigned char* w_ = args.ws; asm volatile("" : "+s"(w_)); b_.bar = (unsigned*)(w_ + WS_CTL) + CW_BAR; b_.x = xb_xcc_id(); b_.st = (volatile LAS unsigned*)(F.lds + LDSCTL_OFF) + 8; b_.w = wave_s; xcd_barrier(b_); RELAUNDER(); } while (0)
#define RELAUNDER() do { int t_ = (wave_s << 6) | gm::gm_lane_id(); asm volatile("" : "+v"(t_)); F.tid = t_; F.lane = t_ & 63; F.wave = wave_s; unsigned z_ = 0u; int v_ = vcu0, g_ = (int)gridDim.x; asm volatile("" : "+s"(z_), "+s"(v_), "+s"(g_)); F.lds = (LAS unsigned char*)lds + z_; F.vcu = v_; F.G = g_; } while (0)
#ifndef PHM
#define PHM 0xFFFF
#endif
#define PHMARK(k) asm volatile("; PHASE_MARK " #k ::: "memory")
#ifndef DUPM
#define DUPM 0
#endif
#define NREP(k) ((((DUPM) >> (k)) & 1) ? 2 : 1)
#define PH(k) PHMARK(k); if constexpr ((PHM >> (k)) & 1) _Pragma("unroll 1") for (int rep_ = 0; rep_ < NREP(k); ++rep_)
#ifndef NPASS
#define NPASS 1
#endif
  _Pragma("unroll 1") for (int pass_ = 0; pass_ < NPASS; ++pass_) {
    PH(0) p0_prologue(args, F);
    GRID_BAR();

#pragma unroll 1
    for (int l = 0; l < NL; ++l) {
        RELAUNDER();
        const __attribute__((address_space(4))) Args* ka = (const __attribute__((address_space(4))) Args*)__builtin_amdgcn_kernarg_segment_ptr(); asm volatile("" : "+s"(ka));
#define AIN(k) (ka->in[k])
        unsigned char* ws = ka->ws; float* out = ka->out; asm volatile("" : "+s"(ws), "+s"(out));
        bf16* const XB = (bf16*)(ws + WS_XB);
        const size_t mask_off = (l == 0) ? WS_MASK : WS_XB;
        PH(1) {   gm::ProbDense<1> P{(const char*)XB, nullptr, nullptr, (const char*)(ws + WS_WIN + (size_t)l * WIN_BYTES), S, N1, D, D, F.G, (int)blockIdx.x};
            gm::EpiProj E{ws, (const float*)(ws + WS_BIAS) + (size_t)l * N1};
            gm::gemm_phase(F.lds, P, E, F.wave); }
        if (l == 0 && blockIdx.x >= 64 && blockIdx.x < 72) { RELAUNDER();
            gm::ProbDense<1> PM{(const char*)(ws + WS_MEMB), nullptr, nullptr, (const char*)(ws + WS_WMEM), 256, 2048, D, D, 8, (int)blockIdx.x - 64};
            gm::EpiMemKV EM{(bf16*)(ws + WS_MEMK), (bf16*)(ws + WS_MEMV)};
            gm::gemm_phase(F.lds, PM, EM, F.wave); }
        GRID_BAR();
#ifndef XBAR
#define XBAR 0
#endif
        for (int xb_ = 0; xb_ < XBAR; ++xb_) GRID_BAR();
        PH(2) pool_diff((const bf16*)(ws + WS_PU), (bf16*)(ws + WS_PD), F);
        RELAUNDER();
        PH(3) for (int u = F.vcu; u < 256; u += F.G) { const int h = u & 3;
            ma::mem_unit(u >> 2, h, (const bf16*)(ws + WS_MEMK) + (size_t)(l * 4 + h) * 256 * 128, (const bf16*)(ws + WS_MEMV) + (size_t)(l * 4 + h) * 128 * 256, (bf16*)(ws + WS_MQ), (bf16*)(ws + ((NREP(3) == 2 && rep_ == 0) ? ((l == 0) ? WS_XB : WS_MASK) : WS_MQ)), F.lds, F.tid, F.lane, F.wave); }
        RELAUNDER();
        PH(4) for (int p = F.vcu; p < 256; p += F.G) {
            ix::indexer_unit(511 - p, (const bf16*)(ws + WS_IQ), (const bf16*)(ws + WS_IK), (const float*)(ws + WS_IW), (unsigned long long*)(ws + mask_off), F.lds, F.tid, F.lane, F.wave, IXDRY != 0 && NREP(4) == 2 && rep_ == 0);
            ix::indexer_unit(p, (const bf16*)(ws + WS_IQ), (const bf16*)(ws + WS_IK), (const float*)(ws + WS_IW), (unsigned long long*)(ws + mask_off), F.lds, F.tid, F.lane, F.wave, IXDRY != 0 && NREP(4) == 2 && rep_ == 0); }
        GRID_BAR();
        PH(5) {
            const attn_body::AttnTensors AT{(const attn_body::bf16*)(ws + WS_Q), (const attn_body::bf16*)(ws + WS_K), (const attn_body::bf16*)(ws + WS_V), (attn_body::bf16*)(ws + ((NREP(5) == 2 && rep_ == 0) ? WS_PU : WS_Q)), (const unsigned long long*)(ws + mask_off), F.wave};
            const attn_body::StaticOrder SO((int)F.G, (int)blockIdx.x);
            attn_body::attn_phase<attn_body::StaticOrder>((char*)lds, AT, SO); }
        GRID_BAR();
        PH(6) {   gm::ProbDense<3> P{(const char*)(ws + WS_PD), (const char*)(ws + WS_Q), (const char*)(ws + WS_MQ), (const char*)(ws + WS_WBR + (size_t)l * WBR_BYTES), S, D, 1536, 512, F.G, (int)blockIdx.x};
            gm::EpiMerge E{(const bf16*)(ws + WS_GATE), XB};
            gm::gemm_phase(F.lds, P, E, F.wave); }
        GRID_BAR();
        PHMARK(7); _Pragma("unroll 1") for (int rep_ = 0; rep_ < ((l == 0) ? NREP(7) : 1); ++rep_) {   gm::ProbDense<1> P{(const char*)XB, nullptr, nullptr, (const char*)(ws + WS_WOUT + (size_t)l * WOUT_BYTES), S, D, D, D, F.G, (int)blockIdx.x};
            gm::EpiRes E{(l == 0) ? AIN(0) : (const float*)out, out};
            gm::gemm_phase(F.lds, P, E, F.wave); }
        GRID_BAR();
        GAS unsigned* ecnt = F.ctl + CW_ECNT + (pass_ * NL + l) * 16 * 64;
        unsigned* toks = (unsigned*)(ws + WS_TOK) + (size_t)l * NEXP * CAPE; float* gl = (float*)(ws + WS_GL) + (size_t)l * NEXP * CAPE;
        PH(8) ln1_route(out, (NREP(8) == 2 && rep_ == 0) ? (float*)(ws + WS_O2) : out, !(NREP(8) == 2 && rep_ == 0), XB, AIN(10) + (size_t)l * D, AIN(11) + (size_t)l * D, AIN(12), AIN(13), toks, gl, ecnt, F);
        RELAUNDER();
        PH(9) moe_weights(AIN(14) + (size_t)l * NEXP * D * DEXP, AIN(15) + (size_t)l * NEXP * D * DEXP, AIN(16) + (size_t)l * NEXP * DEXP * D, (bf16*)(ws + WS_W13), (bf16*)(ws + WS_W2T), F);
        GRID_BAR();
        {   LAS int* tl = (LAS int*)(F.lds + LDSCTL_OFF + 64);
            if (F.tid < 64) { const int e = F.tid & 15; const int c = (int)__hip_atomic_load(ecnt + 64 * e, __ATOMIC_RELAXED, __HIP_MEMORY_SCOPE_AGENT); const int nb = (c + 255) >> 8; int x = nb;
#pragma unroll
                for (int o = 1; o < 16; o <<= 1) { const int y = __shfl_up(x, o); if ((F.tid & 15) >= o) x += y; }
                if (F.tid < 16) { tl[e] = x - nb; tl[17 + e] = c; if (e == 15) tl[16] = x; } }
            LDS_WAIT(); __syncthreads();
            PH(10) { gm::ProbMoe<true> P1{(const char*)XB, (const char*)(ws + WS_W13), (const int*)toks, D, D, F.G, F.vcu, tl};
            gm::EpiSwiglu E1{(bf16*)(ws + WS_H)};
            gm::gemm_phase(F.lds, P1, E1, F.wave); }
            GRID_BAR();
            PH(11) { gm::ProbMoe<false> P2{(const char*)(ws + WS_H), (const char*)(ws + WS_W2T), (const int*)toks, DEXP, DEXP, F.G, F.vcu, tl};
            gm::EpiMoeOut E2{toks, gl, tl + 17, (bf16*)(ws + WS_O2)};
            gm::gemm_phase(F.lds, P2, E2, F.wave); }
        }
        GRID_BAR();
        PH(12) ln2_rows(out, (NREP(12) == 2 && rep_ == 0) ? (float*)(ws + WS_W13) : out, (const bf16*)(ws + WS_O2), XB, AIN(17) + (size_t)l * D, AIN(18) + (size_t)l * D, F);
        if (l + 1 < NL || pass_ + 1 < NPASS) GRID_BAR();
    }
  }
}

extern "C" void kernel_launch(void* const* d_in, const int* in_sizes, int n_in, void* d_out, int out_size, void* d_ws, size_t ws_size, hipStream_t stream) {
    static int grid = 0;
    if (grid == 0) {
        if (n_in != 19 || in_sizes[0] != S * D || out_size != S * D || ws_size < WS_END) { fprintf(stderr, "kernel_launch: unexpected problem (n_in %d, in0 %d, out %d, ws %zu < %zu); nothing launched\n", n_in, n_in > 0 ? in_sizes[0] : -1, out_size, ws_size, (size_t)WS_END); grid = -1; return; }
        int dev = 0, cus = 0, per_cu = 0;
        if (hipGetDevice(&dev) != hipSuccess || hipDeviceGetAttribute(&cus, hipDeviceAttributeMultiprocessorCount, dev) != hipSuccess) { grid = -1; return; }
        if (hipFuncSetAttribute((const void*)hybrid_fwd, hipFuncAttributeMaxDynamicSharedMemorySize, LDS_BYTES) != hipSuccess) { fprintf(stderr, "kernel_launch: hipFuncSetAttribute failed\n"); grid = -1; return; }
        if (hipOccupancyMaxActiveBlocksPerMultiprocessor(&per_cu, (const void*)hybrid_fwd, NWAVES * 64, LDS_BYTES) != hipSuccess || per_cu < 1) { fprintf(stderr, "kernel_launch: occupancy query reports %d workgroups per CU\n", per_cu); }
        (void)hipGetLastError();
        grid = cus;
    }
    if (grid < 0) return;
    if (hipMemsetAsync((char*)d_ws + WS_CTL, 0, CTL_ZERO_BYTES, stream) != hipSuccess) return;
    Args a{};
    for (int i = 0; i < 19; ++i) a.in[i] = (const float*)d_in[i];
    a.out = (float*)d_out; a.ws = (unsigned char*)d_ws;
    hipLaunchKernelGGL(hybrid_fwd, dim3(grid), dim3(NWAVES * 64), LDS_BYTES, stream, a);
}
```

```cpp
#include <hip/hip_runtime.h>
#include <hip/hip_bf16.h>
#include <cstdio>
#include <cstdint>
#include <cmath>

namespace gm {
#define GM_LAS __attribute__((address_space(3)))
typedef unsigned short bf16_t;
typedef short bf16x8 __attribute__((ext_vector_type(8)));
typedef float f32x4 __attribute__((ext_vector_type(4)));
typedef float f32x2 __attribute__((ext_vector_type(2)));
typedef unsigned u32x4 __attribute__((ext_vector_type(4)));
typedef unsigned u32x2 __attribute__((ext_vector_type(2)));
constexpr int BM = 256, BK = 64, HALF = 128, HTB = HALF * BK * 2  , STAGE_BYTES = 8 * HTB, NXCD = 8, WGM = 7;

__host__ __device__ __forceinline__ int lds_byte(int r, int c) { const int st = (r >> 4) * 2 + (c >> 5), rr = r & 15, cc = c & 31, ob = rr * 64 + cc * 2; return st * 1024 + (ob ^ (((ob >> 9) & 1) << 5)); }
__host__ __device__ __forceinline__ void stage_rc(int b, int& R, int& C) { const int st = b / 1024, sb = b % 1024, swz = sb ^ (((sb >> 9) & 1) << 5); R = (st >> 1) * 16 + swz / 64; C = (st & 1) * 32 + (swz % 64) / 2; }
__host__ __device__ __forceinline__ int perm32(int rho) { const int n = rho >> 4, i = rho & 15; return 8 * (i >> 2) + 4 * n + (i & 3); }

struct UnitX { int pm, pn, e, blk, nvalid; const char* A0; const char* A1; const char* A2; const char* B; const int* rows; };

__device__ __forceinline__ bool static_unit(long L, int nM, int nN, int wgm, int& pm, int& pn) {
    const int nwg = nM * nN; if (L >= nwg) return false;
    int wgid = (int)L; { const int q = nwg / NXCD, r = nwg % NXCD, xcd = wgid % NXCD, off = wgid / NXCD; wgid = (xcd < r ? xcd * (q + 1) : r * (q + 1) + (xcd - r) * q) + off; }
    const int nig = wgm * nN, gid = wgid / nig, fm = gid * wgm, gsz = (nM - fm) < wgm ? (nM - fm) : wgm;
    pm = fm + ((wgid % nig) % gsz); pn = (wgid % nig) / gsz; return true;
}
__device__ __forceinline__ unsigned cvt_pk_bf16(float lo, float hi) { unsigned r; asm volatile("v_cvt_pk_bf16_f32 %0, %1, %2" : "=v"(r) : "v"(lo), "v"(hi)); return r; }
__device__ __forceinline__ float bf_lo(unsigned w) { return __uint_as_float(w << 16); }
__device__ __forceinline__ float bf_hi(unsigned w) { return __uint_as_float(w & 0xffff0000u); }

__device__ __forceinline__ int gm_lane_id() { int l; asm volatile("v_mbcnt_lo_u32_b32 %0, -1, 0\n\tv_mbcnt_hi_u32_b32 %0, -1, %0" : "=v"(l)); return l; }
template <class Prob, class Epi>
__device__ __forceinline__ void gemm_phase(GM_LAS unsigned char* lds, const Prob& P, const Epi& E, int wave_id) {
    int tid_ = (wave_id << 6) | gm_lane_id(); asm volatile("" : "+v"(tid_));
    const int tid = tid_, wid = __builtin_amdgcn_readfirstlane(tid >> 6), lane = tid & 63, wr = wid >> 2, wc = wid & 3, fr = lane & 15, fq = lane >> 4;
    const int K = P.K, nt = K / BK, lda = P.lda;
    unsigned voffB[2];
#pragma unroll
    for (int i = 0; i < 2; ++i) { int R, C; stage_rc(tid * 16 + i * 8192, R, C); const int Rb = Epi::PERM ? ((R & ~31) + perm32(R & 31)) : R; voffB[i] = (unsigned)(Rb * K + C) * 2u; }
    const size_t kstep = (size_t)(BK * 2);
    const size_t hstepB = (size_t)HALF * K * 2;
    const size_t hstepA = Prob::GATHER ? (size_t)0 : (size_t)HALF * lda * 2;
    const unsigned ldsw = (unsigned)wid * 1024u;
    const int aoff = lds_byte(wr * 64 + fr, fq * 8), boff = lds_byte(wc * 32 + fr, fq * 8);
#define GM_SA(b, h) (((b) * 2 + (h)) * HTB)
#define GM_SB(b, h) ((4 + (b) * 2 + (h)) * HTB)
#define GM_STAGE(bufoff, gbase, voff) do { _Pragma("unroll") for (int _i = 0; _i < 2; ++_i) \
        __builtin_amdgcn_global_load_lds((const unsigned*)((const char*)(gbase) + (voff)[_i]), (GM_LAS unsigned*)(lds + (bufoff) + ldsw + _i * 8192), 16, 0, 0); } while (0)
#define GM_LDA(dst, b, h) do { _Pragma("unroll") for (int m = 0; m < 4; ++m) _Pragma("unroll") for (int k = 0; k < 2; ++k) dst[m][k] = *(const GM_LAS bf16x8*)(lds + GM_SA(b, h) + aoff + m * 2048 + k * 1024); } while (0)
#define GM_LDB(dst, b, h) do { _Pragma("unroll") for (int n = 0; n < 2; ++n) _Pragma("unroll") for (int k = 0; k < 2; ++k) dst[n][k] = *(const GM_LAS bf16x8*)(lds + GM_SB(b, h) + boff + n * 2048 + k * 1024); } while (0)
#define GM_MMA(ai, bj, At, Bt) do { __builtin_amdgcn_s_setprio(1); _Pragma("unroll") for (int m = 0; m < 4; ++m) _Pragma("unroll") for (int n = 0; n < 2; ++n) _Pragma("unroll") for (int k = 0; k < 2; ++k) \
        acc[ai][bj][m][n] = __builtin_amdgcn_mfma_f32_16x16x32_bf16(Bt[n][k], At[m][k], acc[ai][bj][m][n], 0, 0, 0); __builtin_amdgcn_s_setprio(0); } while (0)
#define GM_WAIT_V(n) asm volatile("s_waitcnt vmcnt(" #n ")" ::: "memory")
#define GM_WAIT_L(n) asm volatile("s_waitcnt lgkmcnt(" #n ")" ::: "memory")
#define GM_BAR __builtin_amdgcn_s_barrier()
#define GM_SCHED __builtin_amdgcn_sched_barrier(0)
#define GM_APTR(u, t) ((Prob::NSEG == 3) ? ((((t) >> 3) == 0 ? (u).A0 : (((t) >> 3) == 1 ? (u).A1 : (u).A2)) + (size_t)((t) & 7) * kstep) : ((u).A0 + (size_t)(t) * kstep))
#define GM_VOFF(u, v) do { int _t = tid; asm volatile("" : "+v"(_t)); _Pragma("unroll") for (int _i = 0; _i < 2; ++_i) { int _R, _C; stage_rc(_t * 16 + _i * 8192, _R, _C); \
        _Pragma("unroll") for (int _h = 0; _h < 2; ++_h) { const int _ix = _h * HALF + _R; \
            const unsigned _r = Prob::GATHER ? ((_ix < (u).nvalid) ? ((unsigned)((const __attribute__((address_space(1))) int*)(u).rows)[_ix] >> 1) : 0u) : (unsigned)_R; (v)[_h][_i] = _r * (unsigned)lda * 2u + (unsigned)_C * 2u; } } } while (0)
#define GM_VA(arr, h) (arr)[Prob::GATHER ? (h) : 0]
    UnitX cur, nxt; int ui = 0;
    if (!P.next(0, cur)) return;
    f32x4 acc[2][2][4][2];
#pragma unroll
    for (int a = 0; a < 2; ++a)
#pragma unroll
        for (int b = 0; b < 2; ++b)
#pragma unroll
            for (int m = 0; m < 4; ++m)
#pragma unroll
                for (int n = 0; n < 2; ++n) acc[a][b][m][n] = (f32x4){0.f, 0.f, 0.f, 0.f};
    bf16x8 At[4][2], B0[2][2], B1[2][2];
    unsigned vA[2][2];
    GM_LAS u32x4* nv_slot = (GM_LAS u32x4*)(lds + STAGE_BYTES) + tid;
    GM_VOFF(cur, vA);
    {
        const char* a0 = GM_APTR(cur, 0); const char* b0 = cur.B;
        GM_STAGE(GM_SB(0, 0), b0, voffB); GM_STAGE(GM_SB(0, 1), b0 + hstepB, voffB); GM_STAGE(GM_SA(0, 0), a0, GM_VA(vA, 0)); GM_STAGE(GM_SA(0, 1), a0 + hstepA, GM_VA(vA, 1));
        if (wr == 1) GM_BAR;
        GM_WAIT_V(2); GM_BAR;
        GM_STAGE(GM_SB(1, 0), b0 + kstep, voffB); GM_STAGE(GM_SA(1, 0), a0 + kstep, GM_VA(vA, 0)); GM_STAGE(GM_SB(1, 1), b0 + hstepB + kstep, voffB);
        GM_WAIT_V(6); GM_BAR;
    }
    for (;;) {
        const bool has_next = P.next(ui + 1, nxt);
        if (!has_next) nxt = cur;
        if (Prob::GATHER) { unsigned nv_[2][2]; GM_VOFF(nxt, nv_); *nv_slot = (u32x4){nv_[0][0], nv_[0][1], nv_[1][0], nv_[1][1]}; }
        for (int t = 0; t < nt; t += 2) {
            const bool last = (t == nt - 2);
            if constexpr (Epi::HAS_MID) { if (t == 8 || t == 16) E.mid(acc, cur, t, wr, wc, fr, fq); }
            const char* a1 = GM_APTR(cur, t + 1);
            const char* a2 = last ? GM_APTR(nxt, 0) : GM_APTR(cur, t + 2);
            const char* b2 = last ? nxt.B : cur.B + (size_t)(t + 2) * kstep;
            const char* a3 = a2 + kstep; const char* b3 = b2 + kstep;
            unsigned v2[2][2];
            if (Prob::GATHER && last) { const u32x4 q_ = *nv_slot; v2[0][0] = q_.x; v2[0][1] = q_.y; v2[1][0] = q_.z; v2[1][1] = q_.w; }
            else {
#pragma unroll
                for (int h = 0; h < 2; ++h)
#pragma unroll
                    for (int i = 0; i < 2; ++i) v2[h][i] = vA[h][i]; }
            GM_LDB(B0, 0, 0); GM_LDB(B1, 0, 1); GM_SCHED; GM_LDA(At, 0, 0); GM_STAGE(GM_SA(1, 1), a1 + hstepA, GM_VA(vA, 1));
            GM_WAIT_V(8); GM_WAIT_L(0); GM_BAR; GM_MMA(0, 0, At, B0); GM_MMA(0, 1, At, B1); GM_BAR; GM_SCHED;
            GM_LDA(At, 0, 1); GM_STAGE(GM_SB(0, 0), b2, voffB); GM_STAGE(GM_SB(0, 1), b2 + hstepB, voffB); GM_STAGE(GM_SA(0, 0), a2, GM_VA(v2, 0));
            GM_WAIT_V(8); GM_WAIT_L(0); GM_BAR; GM_MMA(1, 0, At, B0); GM_MMA(1, 1, At, B1); GM_BAR; GM_SCHED;
            GM_LDB(B0, 1, 0); GM_LDB(B1, 1, 1); GM_SCHED; GM_LDA(At, 1, 0); GM_STAGE(GM_SA(0, 1), a2 + hstepA, GM_VA(v2, 1));
            GM_WAIT_V(8); GM_WAIT_L(0); GM_BAR; GM_MMA(0, 0, At, B0); GM_MMA(0, 1, At, B1); GM_BAR; GM_SCHED;
            GM_LDA(At, 1, 1); GM_STAGE(GM_SB(1, 0), b3, voffB); GM_STAGE(GM_SB(1, 1), b3 + hstepB, voffB); GM_STAGE(GM_SA(1, 0), a3, GM_VA(v2, 0));
            GM_WAIT_V(8); GM_WAIT_L(0); GM_BAR; GM_MMA(1, 0, At, B0); GM_MMA(1, 1, At, B1); GM_BAR; GM_SCHED;
        }
        if (wr == 0) GM_BAR;
        E(acc, cur, wr, wc, fr, fq);
        if (!has_next) break;
#pragma unroll
        for (int a = 0; a < 2; ++a)
#pragma unroll
            for (int b = 0; b < 2; ++b)
#pragma unroll
                for (int m = 0; m < 4; ++m)
#pragma unroll
                    for (int n = 0; n < 2; ++n) acc[a][b][m][n] = (f32x4){0.f, 0.f, 0.f, 0.f};
        cur = nxt; ++ui;
        if (Prob::GATHER) { const u32x4 q_ = *nv_slot; vA[0][0] = q_.x; vA[0][1] = q_.y; vA[1][0] = q_.z; vA[1][1] = q_.w; }
        if (wr == 1) GM_BAR;
    }
    GM_WAIT_V(0);
    GM_BAR;
#undef GM_SA
#undef GM_SB
#undef GM_STAGE
#undef GM_LDA
#undef GM_LDB
#undef GM_MMA
#undef GM_WAIT_V
#undef GM_WAIT_L
#undef GM_BAR
#undef GM_SCHED
#undef GM_APTR
#undef GM_VOFF
#undef GM_VA
}
}

#ifndef IXDRY
#define IXDRY 0
#endif
#ifndef WGM_P1
#define WGM_P1 7
#endif
#ifndef WGM_P4
#define WGM_P4 7
#endif
#ifndef WGM_P5
#define WGM_P5 7
#endif
#ifndef IXMIXON
#define IXMIXON 1
#endif
constexpr int NWAVES = 8;
constexpr int S = 16384, D = 1024, NL = 2, DIN = 6216, N1 = 6400;
constexpr int NEXP = 16, DEXP = 512, CAPE = 16384;
constexpr float LN_EPS = 1e-5f;
constexpr float DN_ALPHA = 1.4142135623730951f;
constexpr float LOG2E = 1.4426950408889634f;
constexpr float Q_SCALE = 0.125f * LOG2E;
constexpr float IQ_SCALE = 0.125f;
constexpr float IW_SCALE = 0.35355339059327373f;
constexpr float MQ_SCALE = 0.08838834764831845f * LOG2E;
__host__ __device__ __forceinline__ int rot_dim(int jj) { const int g = jj >> 3, i = jj & 7; return (i < 4) ? 4 * g + i : 32 + 4 * g + (i - 4); }
__host__ __device__ __forceinline__ int in_src_col(int j) {
    if (j < 512) return j;
    if (j < 1536) { const int b = (j < 1024) ? 512 : 1024, jj = j - b; return b + (jj & ~63) + rot_dim(jj & 63); }
    if (j < 2048) return j;
    if (j < 2560) { const int jj = j - 2048; return 2048 + (jj & ~63) + rot_dim(jj & 63); }
    if (j < 3072) return 2632 + (j - 2560);
    if (j < 6144) return 3144 + (j - 3072);
    if (j < 6208) return 2560 + rot_dim(j - 6144);
    if (j < 6216) return 2624 + (j - 6208);
    return -1;
}
constexpr size_t MiB = 1u << 20;
constexpr size_t WS_CTL = 0, CTL_ZERO_BYTES = 128 * 1024;
constexpr size_t WS_RCOS = 1 * MiB, WS_RSIN = 3 * MiB;
constexpr size_t WS_MEMK = 5 * MiB, WS_MEMV = 5 * MiB + 512 * 1024;
constexpr size_t WS_TOK = 6 * MiB, WS_GL = 8 * MiB;
constexpr size_t WS_BIAS = 10 * MiB;
constexpr size_t WS_WIN = 11 * MiB, WIN_BYTES = (size_t)N1 * D * 2;
constexpr size_t WS_WBR = 36 * MiB, WBR_BYTES = (size_t)D * 1536 * 2;
constexpr size_t WS_WOUT = 42 * MiB, WOUT_BYTES = (size_t)D * D * 2;
constexpr size_t WS_XB = 46 * MiB;
constexpr size_t WS_PD = 78 * MiB;
constexpr size_t WS_MASK = 94 * MiB;
constexpr size_t WS_PU = 126 * MiB, WS_Q = 142 * MiB, WS_K = 158 * MiB, WS_V = 174 * MiB, WS_IQ = 190 * MiB, WS_MQ = 206 * MiB;
static_assert(WS_Q == WS_PU + 16 * MiB && WS_K == WS_PU + 32 * MiB && WS_V == WS_PU + 48 * MiB && WS_IQ == WS_PU + 64 * MiB && WS_MQ == WS_PU + 80 * MiB, "segment spacing");
constexpr size_t WS_IK = 222 * MiB, WS_IW = 224 * MiB, WS_GATE = 225 * MiB, WS_WMEM = 321 * MiB, WS_MEMB = 325 * MiB, WS_END = 326 * MiB;
constexpr size_t WS_W13 = 126 * MiB, WS_W2T = 158 * MiB, WS_H = 174 * MiB, WS_O2 = 210 * MiB;
static_assert(WS_WIN + 2 * WIN_BYTES <= WS_WBR && WS_WBR + 2 * WBR_BYTES <= WS_WOUT && WS_WOUT + 2 * WOUT_BYTES <= WS_XB && WS_GATE + (size_t)S * 3072 * 2 <= WS_END && WS_O2 + (size_t)S * 2 * D * 2 <= WS_END && WS_H + (size_t)36864 * 512 * 2 <= WS_O2, "d_ws map");
constexpr int CW_TMO = 0, CW_BAR = 4096, CW_ECNT = 16384;
static_assert((CW_ECNT + 4 * 16 * 64) * 4 <= (int)CTL_ZERO_BYTES, "control words inside the per-call memset");
constexpr int LDS_BYTES = 163840, LDSCTL_OFF = LDS_BYTES - 256;

#define GAS __attribute__((address_space(1)))
#define LAS __attribute__((address_space(3)))
typedef unsigned short bf16;
typedef unsigned v4u __attribute__((ext_vector_type(4)));
typedef float f32x4 __attribute__((ext_vector_type(4)));
typedef float f32x16 __attribute__((ext_vector_type(16)));
typedef short bf16x8 __attribute__((ext_vector_type(8)));
#define LDS_WAIT() asm volatile("s_waitcnt lgkmcnt(0)" ::: "memory")
#define VM_WAIT() asm volatile("s_waitcnt vmcnt(0)" ::: "memory")
__device__ __forceinline__ unsigned f2bf(float f) { unsigned u = __builtin_bit_cast(unsigned, f); return (u + 0x7fffu + ((u >> 16) & 1u)) >> 16; }
__device__ __forceinline__ unsigned pk2(float lo, float hi) { return f2bf(lo) | (f2bf(hi) << 16); }
__device__ __forceinline__ float wave_sum(float v) {
#pragma unroll
    for (int o = 1; o < 64; o <<= 1) v += __shfl_xor(v, o);
    return v;
}
namespace attn_body {
using bf16=__hip_bfloat16;
using bf16x8=__attribute__((ext_vector_type(8)))short;
using s16x4=__attribute__((ext_vector_type(4)))short;
using f32x16=__attribute__((ext_vector_type(16)))float;
using u32x4=__attribute__((ext_vector_type(4)))unsigned;
using u32x16_t=__attribute__((ext_vector_type(16)))unsigned;
constexpr int BATCH=1,NHEAD=8,SEQ=16384,D=64,DM=NHEAD*D;
constexpr int NW=8,QBLK=32,QB=QBLK*NW,KVBLK=64,NQB=SEQ/QB;
constexpr int ATTN_PITCH=DM, ATTN_UNIT_ROWS=QB;
__device__ __forceinline__ int crow(int r,int hi){return (r&3)+8*(r>>2)+4*hi;}
#define SBAR() __builtin_amdgcn_sched_barrier(0)
__device__ __forceinline__ void cmask(f32x16&p0,f32x16&p1,int jb,int qrel,int hi){
  const float NEG=-INFINITY; int kb=64*jb+4*hi;
  #pragma unroll
  for(int r=0;r<16;++r){int kv=kb+(r&3)+8*(r>>2); if(kv>qrel)p0[r]=NEG; if(kv+32>qrel)p1[r]=NEG;}
}

constexpr int NSLOT=3, SLOTB=8192;
constexpr int LDS_K=0, LDS_V=NSLOT*SLOTB, LDS_WS=2*NSLOT*SLOTB, LDS_OST=LDS_WS+NW*64*4, LDS_BYTES=LDS_OST+NW*4096;
constexpr float C2=0.125f*1.4426950408889634f;
__device__ __forceinline__ void glds16(const void*gsrc,unsigned lds_dst){unsigned keep;
  asm volatile("s_mov_b32 %0, m0\n\ts_mov_b32 m0, %2\n\ts_nop 0\n\tglobal_load_lds_dwordx4 %1, off\n\ts_mov_b32 m0, %0":"=&s"(keep):"v"(gsrc),"s"(lds_dst):"memory");}
__device__ __forceinline__ float max3f(float a,float b,float c){float r;asm("v_max3_f32 %0, %1, %2, %3":"=v"(r):"v"(a),"v"(b),"v"(c));return r;}
__device__ __forceinline__ float max2f(float a,float b){float r;asm("v_max_f32_e32 %0, %1, %2":"=v"(r):"v"(a),"v"(b));return r;}
__device__ __forceinline__ float fadd_s(float a,float b){float r;asm("v_add_f32_e32 %0, %1, %2":"=v"(r):"v"(a),"v"(b));return r;}
__device__ __forceinline__ float fsub_s(float a,float b){float r;asm("v_sub_f32_e32 %0, %1, %2":"=v"(r):"v"(a),"v"(b));return r;}
typedef float f32x2_t __attribute__((ext_vector_type(2))); typedef __bf16 bf16x2_t __attribute__((ext_vector_type(2)));
__device__ __forceinline__ unsigned cvtpk_s(float lo,float hi){f32x2_t v={lo,hi};bf16x2_t b=__builtin_convertvector(v,bf16x2_t);return __builtin_bit_cast(unsigned,b);}
#define WAIT_BAR(N) asm volatile("s_waitcnt vmcnt(" #N ") lgkmcnt(0)\n\ts_barrier":::"memory")

__device__ __forceinline__ void qkt(f32x16&p0,f32x16&p1,const char*Kslot,const bf16x8*qr,const f32x16&negm,int r32,int hi){
  const char*kb=Kslot+hi*1024+r32*16;
  #pragma unroll
  for(int d0=0;d0<4;++d0){
    const bf16x8 b0=*reinterpret_cast<const bf16x8*>(kb+d0*2048);
    const bf16x8 b1=*reinterpret_cast<const bf16x8*>(kb+d0*2048+512);
    if(d0==0){p0=__builtin_amdgcn_mfma_f32_32x32x16_bf16(b0,qr[0],negm,0,0,0);p1=__builtin_amdgcn_mfma_f32_32x32x16_bf16(b1,qr[0],negm,0,0,0);}
    else{p0=__builtin_amdgcn_mfma_f32_32x32x16_bf16(b0,qr[d0],p0,0,0,0);p1=__builtin_amdgcn_mfma_f32_32x32x16_bf16(b1,qr[d0],p1,0,0,0);}}
}
typedef __attribute__((address_space(3))) const char* lds_cptr;
typedef short v4i16_t __attribute__((ext_vector_type(4)));
__device__ __forceinline__ void kload8(bf16x8*kf,lds_cptr kp){
  kf[0]=*(const __attribute__((address_space(3))) bf16x8*)(kp);      kf[1]=*(const __attribute__((address_space(3))) bf16x8*)(kp+512);
  kf[2]=*(const __attribute__((address_space(3))) bf16x8*)(kp+2048); kf[3]=*(const __attribute__((address_space(3))) bf16x8*)(kp+2560);
  kf[4]=*(const __attribute__((address_space(3))) bf16x8*)(kp+4096); kf[5]=*(const __attribute__((address_space(3))) bf16x8*)(kp+4608);
  kf[6]=*(const __attribute__((address_space(3))) bf16x8*)(kp+6144); kf[7]=*(const __attribute__((address_space(3))) bf16x8*)(kp+6656);
}
__device__ __forceinline__ void kload2(bf16x8*kf,lds_cptr kp,int j){ kf[2*j]=*(const __attribute__((address_space(3))) bf16x8*)(kp+j*2048); kf[2*j+1]=*(const __attribute__((address_space(3))) bf16x8*)(kp+j*2048+512); }
__device__ __forceinline__ s16x4 vtr(lds_cptr p){ return __builtin_bit_cast(s16x4,__builtin_amdgcn_ds_read_tr16_b64_v4i16((__attribute__((address_space(3))) v4i16_t*)p)); }
__device__ __forceinline__ float rowmax(const f32x16&p0,const f32x16&p1){
  float a=max3f(p0[0],p0[1],p1[0]),b=max3f(p0[2],p0[3],p1[1]);a=max3f(a,p1[2],p1[3]);
  #pragma unroll
  for(int r=4;r<16;r+=4){a=max3f(a,p0[r],p0[r+1]);b=max3f(b,p0[r+2],p0[r+3]);a=max3f(a,p1[r],p1[r+1]);b=max3f(b,p1[r+2],p1[r+3]);}
  const float m=max2f(a,b);
  auto rr=__builtin_amdgcn_permlane32_swap(__float_as_uint(m),__float_as_uint(m),false,false);
  return max2f(__uint_as_float(rr[0]),__uint_as_float(rr[1]));
}
__device__ __forceinline__ void pv(f32x16*o,int vb,bf16x8 pa0,bf16x8 pa1,bf16x8 pa2,bf16x8 pa3){
  #pragma unroll
  for(int d0=0;d0<2;++d0){s16x4 lo[4],hi[4];
    #pragma unroll
    for(int ks=0;ks<4;++ks){
      asm volatile("ds_read_b64_tr_b16 %0,%1 offset:%c2":"=&v"(lo[ks]):"v"(vb),"i"(d0*4096+ks*1024):"memory");
      asm volatile("ds_read_b64_tr_b16 %0,%1 offset:%c2":"=&v"(hi[ks]):"v"(vb),"i"(d0*4096+ks*1024+512):"memory");}
    asm volatile("s_waitcnt lgkmcnt(0)":::"memory");SBAR();
    #define PK(k) (bf16x8){lo[k][0],lo[k][1],lo[k][2],lo[k][3],hi[k][0],hi[k][1],hi[k][2],hi[k][3]}
    o[d0]=__builtin_amdgcn_mfma_f32_32x32x16_bf16(pa0,PK(0),o[d0],0,0,0);
    o[d0]=__builtin_amdgcn_mfma_f32_32x32x16_bf16(pa1,PK(1),o[d0],0,0,0);
    o[d0]=__builtin_amdgcn_mfma_f32_32x32x16_bf16(pa2,PK(2),o[d0],0,0,0);
    o[d0]=__builtin_amdgcn_mfma_f32_32x32x16_bf16(pa3,PK(3),o[d0],0,0,0);
    #undef PK
  }
}

#ifndef ATTN_STORE16
#define ATTN_STORE16(p,v) (*(u32x4*)(p)=(v))
#endif
template<int THRL> __device__ __forceinline__ void attn_unit(int b,int h,int qb,const bf16*Q,const bf16*__restrict__ K,const bf16*__restrict__ V,bf16*O,const unsigned long long*MT,int wave_id,char*shm){
  int tid_=(wave_id<<6)|gm::gm_lane_id(); asm volatile("":"+v"(tid_)); const int tid=tid_,lane=tid&63,r32=lane&31,hi=lane>>5; const int wid=__builtin_amdgcn_readfirstlane(tid>>6);
  const long rowbase=(long)b*SEQ; const int q0=qb*QB;
  const bf16*Qw=Q+(rowbase+q0+wid*QBLK)*DM+h*D;
  const bf16*Kh=K+rowbase*DM+h*D,*Vh=V+rowbase*DM+h*D;
  const unsigned lds0=(unsigned)(uintptr_t)shm;
  float*wsf=(float*)(shm+LDS_WS)+wid*64;
  const bf16*ksrc=Kh+(long)lane*DM+wid*8;
  const bf16*vsrc=Vh+(long)(16*(wid&3)+(lane>>2))*DM+(wid>>2)*32+(lane&3)*8;
  const unsigned kdst=lds0+LDS_K+wid*1024, vdst=lds0+LDS_V+wid*1024;
  #define DMA_K(t,slot) glds16(ksrc+(long)(t)*KVBLK*DM,(unsigned)__builtin_amdgcn_readfirstlane(kdst+(slot)))
  #define DMA_V(t,slot) glds16(vsrc+(long)(t)*KVBLK*DM,(unsigned)__builtin_amdgcn_readfirstlane(vdst+(slot)))
  const int vb0=(int)(lds0+LDS_V)+((lane>>4)&1)*32+(lane&3)*8+(4*hi+((lane&15)>>2))*64;
  const char*Kbase=shm+LDS_K; bf16x8 kf[8];
  const lds_cptr shm3=(lds_cptr)shm; const lds_cptr kp0=shm3+LDS_K+hi*1024+r32*16; const lds_cptr vp0=shm3+LDS_V+((lane>>4)&1)*32+(lane&3)*8+(4*hi+((lane&15)>>2))*64;
  const int NT=(q0+QB)/KVBLK;
  { const unsigned pd_=(unsigned)__builtin_amdgcn_readfirstlane((int)(lds0+131072+wid*1024)); const char*mb_=(const char*)(MT+((size_t)(qb*8+wid)*256)*32)+lane*16; glds16(mb_,pd_); glds16(mb_+1024,pd_); }
  DMA_K(0,0);DMA_V(0,0);DMA_K(1,SLOTB);
  bf16x8 qr[4];
  #pragma unroll
  for(int d0=0;d0<4;++d0)qr[d0]=*reinterpret_cast<const bf16x8*>(&Qw[(long)r32*DM+d0*16+hi*8]);
  float mhat=0.f,l_reg=0.f;f32x16 o[2];o[0]=f32x16{};o[1]=f32x16{};f32x16 negm=f32x16{};asm volatile("":"+v"(negm));
  const unsigned long long*mw=MT+((size_t)(qb*8+wid)*256)*32;
  u32x16_t mk0,mk1;
  typedef const __attribute__((address_space(4))) u32x16_t* mcptr_t;
  #define MLOAD(t,half) do{ mcptr_t mp_=(mcptr_t)(mw+(size_t)(t)*32+(half)*16); mk0=mp_[0]; mk1=mp_[1]; }while(0)
  #define MSEL(M,i,v) (__builtin_amdgcn_inverse_ballot_w64(((unsigned long long)M[2*(i)+1]<<32)|M[2*(i)])?(v):-INFINITY)
  #define MAPPLY(PX) do{ \
    _Pragma("unroll") for(int r=0;r<8;++r){PX[r]=MSEL(mk0,r,PX[r]);PX[8+r]=MSEL(mk1,r,PX[8+r]);} }while(0)
  #define CMASK(P0,P1,t) do{}while(0)
  MLOAD(0,0);
  const unsigned mpf_dst=(unsigned)__builtin_amdgcn_readfirstlane((int)(lds0+131072+wid*1024));
  #define MPF(t) do{ if((((t)&3)==0)&&((t)+11<NT)){ glds16((const char*)(mw+(size_t)((t)+8)*32)+lane*16,mpf_dst); } }while(0)
  bool resc=false;
  #define START(P0,P1) do{ const float rm=rowmax(P0,P1); resc=false; \
    { const float dl=rm; mhat=fadd_s(mhat,dl); \
      _Pragma("unroll") for(int r=0;r<16;++r){P0[r]=fsub_s(P0[r],dl);P1[r]=fsub_s(P1[r],dl);} \
      _Pragma("unroll") for(int r=0;r<16;++r)negm[r]=-mhat; asm volatile("":"+v"(negm)); } \
    MAPPLY(P0); MLOAD(0,1); \
    _Pragma("unroll") for(int r=0;r<16;++r)P0[r]=__builtin_amdgcn_exp2f(P0[r]); \
    MAPPLY(P1); MLOAD(1,0); }while(0)
  #define RESC() do{ if(resc){ asm volatile("s_waitcnt lgkmcnt(0)":::"memory"); \
      _Pragma("unroll") for(int d_=0;d_<2;++d_) _Pragma("unroll") for(int r=0;r<16;++r)o[d_][r]*=wsf[crow(r,hi)]; } }while(0)
  f32x16 pA0,pA1,pB0,pB1;
  int sl_prev=0,sl_cur=0,sl_next=SLOTB;
  #define ROT() do{sl_prev=sl_cur;sl_cur=sl_next;sl_next=(sl_next==(NSLOT-1)*SLOTB)?0:sl_next+SLOTB;}while(0)
  DMA_K(2,2*SLOTB);
  WAIT_BAR(3);
  qkt(pA0,pA1,Kbase,qr,negm,r32,hi);asm volatile("s_nop 15\n\ts_nop 7":"+v"(pA0),"+v"(pA1));CMASK(pA0,pA1,0);
  START(pA0,pA1);
  _Pragma("unroll") for(int r=0;r<16;++r)pA1[r]=__builtin_amdgcn_exp2f(pA1[r]);
  WAIT_BAR(0);
  DMA_K(3,0);DMA_V(1,SLOTB);
  ROT();
  kload8(kf,kp0+sl_cur);
  WAIT_BAR(2);
  s16x4 vlo[8],vhi[8]; u32x4 pw0,pw1,pw2,pw3;
  #define PKW(P,B) cvtpk_s(P[B],P[B+1])
  #define PAF(k) __builtin_bit_cast(bf16x8,pw##k)
  #define VFR(i) (bf16x8){vlo[i][0],vlo[i][1],vlo[i][2],vlo[i][3],vhi[i][0],vhi[i][1],vhi[i][2],vhi[i][3]}
  #define PIN(x) asm volatile("":"+v"(x))
  #define MX3(a,b,c) __builtin_fmaxf(__builtin_fmaxf((a),(b)),(c))
  #define GAPA(MF,A0,A1,A2,A3,W0,W1,PW) do{ MF; sacc+=A0; sacc+=A1; sacc+=A2; sacc+=A3; PIN(sacc); W0; W1; PIN(PW); SBAR(); }while(0)
  #define EX(v) __builtin_amdgcn_exp2f(v)
  #define GAPB(MF,X,B) do{ MF; X[B]=EX(X[B]); X[B+1]=EX(X[B+1]); X[B+2]=EX(X[B+2]); X[B+3]=EX(X[B+3]); PIN(X); SBAR(); }while(0)
  #define VRD(i) do{ vlo[i]=vtr(vp_+(((i)>>2)*4096+((i)&3)*1024)); vhi[i]=vtr(vp_+(((i)>>2)*4096+((i)&3)*1024+512)); }while(0)
  #define KRD(G,j) do{ if(G){ kload2(kf,kp0+sl_next,j); SBAR(); } }while(0)
  #define STEP(C0,C1,P0,P1,t,GK,GV,GL) do{ SBAR(); MPF(t); \
    const lds_cptr vp_=vp0+sl_prev; \
    VRD(0); SBAR(); float sacc=(P0[0]+P0[1]); \
    GAPA(C0=__builtin_amdgcn_mfma_f32_32x32x16_bf16(kf[0],qr[0],negm,0,0,0), P0[2],P0[3],P0[4],P0[5],     pw0[0]=PKW(P0,0), pw0[1]=PKW(P0,2), pw0); \
    VRD(4); SBAR(); GAPA(C1=__builtin_amdgcn_mfma_f32_32x32x16_bf16(kf[1],qr[0],negm,0,0,0), P0[6],P0[7],P0[8],P0[9],     pw0[2]=PKW(P0,4), pw0[3]=PKW(P0,6), pw0); \
    VRD(1); SBAR(); GAPA(C0=__builtin_amdgcn_mfma_f32_32x32x16_bf16(kf[2],qr[1],C0,0,0,0),   P0[10],P0[11],P0[12],P0[13], pw1[0]=PKW(P0,8), pw1[1]=PKW(P0,10), pw1); \
    VRD(5); SBAR(); GAPA(C1=__builtin_amdgcn_mfma_f32_32x32x16_bf16(kf[3],qr[1],C1,0,0,0),   P0[14],P0[15],P1[0],P1[1],   pw1[2]=PKW(P0,12),pw1[3]=PKW(P0,14), pw1); \
    VRD(2); SBAR(); GAPA(C0=__builtin_amdgcn_mfma_f32_32x32x16_bf16(kf[4],qr[2],C0,0,0,0),   P1[2],P1[3],P1[4],P1[5],     pw2[0]=PKW(P1,0), pw2[1]=PKW(P1,2), pw2); \
    VRD(6); SBAR(); GAPA(C1=__builtin_amdgcn_mfma_f32_32x32x16_bf16(kf[5],qr[2],C1,0,0,0),   P1[6],P1[7],P1[8],P1[9],     pw2[2]=PKW(P1,4), pw2[3]=PKW(P1,6), pw2); \
    VRD(3); SBAR(); GAPA(C0=__builtin_amdgcn_mfma_f32_32x32x16_bf16(kf[6],qr[3],C0,0,0,0),   P1[10],P1[11],P1[12],P1[13], pw3[0]=PKW(P1,8), pw3[1]=PKW(P1,10), pw3); \
    VRD(7); SBAR(); GAPA(C1=__builtin_amdgcn_mfma_f32_32x32x16_bf16(kf[7],qr[3],C1,0,0,0),   P1[14],P1[15],0.f,0.f,       pw3[2]=PKW(P1,12),pw3[3]=PKW(P1,14), pw3); \
    l_reg+=sacc; \
    if(GK){DMA_K((t)+3,sl_cur);} if(GV){DMA_V((t)+1,sl_next);} \
    CMASK(C0,C1,t); \
    { float a=MX3(C0[0],C0[1],C1[0]),b=MX3(C0[2],C0[3],C1[1]); a=MX3(a,C1[2],C1[3]); \
      _Pragma("unroll") for(int r=4;r<16;r+=4){a=MX3(a,C0[r],C0[r+1]);b=MX3(b,C0[r+2],C0[r+3]);a=MX3(a,C1[r],C1[r+1]);b=MX3(b,C1[r+2],C1[r+3]);} \
      float rm=__builtin_fmaxf(a,b); { auto rr=__builtin_amdgcn_permlane32_swap(__float_as_uint(rm),__float_as_uint(rm),false,false); rm=__builtin_fmaxf(__uint_as_float(rr[0]),__uint_as_float(rr[1])); } \
      resc=false; \
      if(__builtin_expect(__any(rm>(float)THRL),0)){ const float dl=__builtin_fmaxf(rm,0.f); mhat+=dl; \
        _Pragma("unroll") for(int r=0;r<16;++r){C0[r]-=dl;C1[r]-=dl;} \
        _Pragma("unroll") for(int r=0;r<16;++r)negm[r]=-mhat; asm volatile("":"+v"(negm)); \
        const float f=__builtin_amdgcn_exp2f(-dl); l_reg*=f; if(hi==0)wsf[r32]=f; resc=true; } } \
    MAPPLY(C0); MLOAD(t,1); \
    SBAR(); \
    GAPB(o[0]=__builtin_amdgcn_mfma_f32_32x32x16_bf16(PAF(0),VFR(0),o[0],0,0,0), C0,0); \
    GAPB(o[1]=__builtin_amdgcn_mfma_f32_32x32x16_bf16(PAF(0),VFR(4),o[1],0,0,0), C0,4); \
    KRD(GL,0); GAPB(o[0]=__builtin_amdgcn_mfma_f32_32x32x16_bf16(PAF(1),VFR(1),o[0],0,0,0), C0,8); \
    KRD(GL,1); GAPB(o[1]=__builtin_amdgcn_mfma_f32_32x32x16_bf16(PAF(1),VFR(5),o[1],0,0,0), C0,12); \
    MAPPLY(C1); if((t)+1<NT){MLOAD((t)+1,0);} SBAR(); \
    KRD(GL,2); GAPB(o[0]=__builtin_amdgcn_mfma_f32_32x32x16_bf16(PAF(2),VFR(2),o[0],0,0,0), C1,0); \
    KRD(GL,3); GAPB(o[1]=__builtin_amdgcn_mfma_f32_32x32x16_bf16(PAF(2),VFR(6),o[1],0,0,0), C1,4); \
    GAPB(o[0]=__builtin_amdgcn_mfma_f32_32x32x16_bf16(PAF(3),VFR(3),o[0],0,0,0), C1,8); \
    GAPB(o[1]=__builtin_amdgcn_mfma_f32_32x32x16_bf16(PAF(3),VFR(7),o[1],0,0,0), C1,12); \
    }while(0)
  int t=1;
  for(;t+5<NT;t+=2){
    STEP(pB0,pB1,pA0,pA1,t,true,true,true);     WAIT_BAR(2); RESC(); ROT();
    STEP(pA0,pA1,pB0,pB1,t+1,true,true,true);   WAIT_BAR(2); RESC(); ROT();
  }
  #define ENDW(tt) do{ if((tt)+3<NT){WAIT_BAR(2);} else if((tt)+2<NT){WAIT_BAR(1);} else {WAIT_BAR(0);} }while(0)
  for(;t+1<NT;t+=2){
    STEP(pB0,pB1,pA0,pA1,t,(t+3<NT),(t+1<NT),(t+1<NT));       ENDW(t);   RESC(); ROT();
    STEP(pA0,pA1,pB0,pB1,t+1,(t+4<NT),(t+2<NT),(t+2<NT));     ENDW(t+1); RESC(); ROT();
  }
  STEP(pB0,pB1,pA0,pA1,NT-1,false,false,false); RESC();
  { float sacc=pB0[0]+pB0[1]; _Pragma("unroll") for(int r=2;r<16;++r)sacc+=pB0[r]; _Pragma("unroll") for(int r=0;r<16;++r)sacc+=pB1[r]; l_reg+=sacc;
    pw0=(u32x4){PKW(pB0,0),PKW(pB0,2),PKW(pB0,4),PKW(pB0,6)};pw1=(u32x4){PKW(pB0,8),PKW(pB0,10),PKW(pB0,12),PKW(pB0,14)};pw2=(u32x4){PKW(pB1,0),PKW(pB1,2),PKW(pB1,4),PKW(pB1,6)};pw3=(u32x4){PKW(pB1,8),PKW(pB1,10),PKW(pB1,12),PKW(pB1,14)};
    SBAR(); pv(o,vb0+sl_cur,PAF(0),PAF(1),PAF(2),PAF(3)); }
  #undef PKW
  #undef PAF
  #undef VFR
  #undef PIN
  #undef MX3
  #undef GAPA
  #undef GAPB
  #undef EX
  #undef VRD
  #undef KRD
  #undef STEP
  #undef ENDW
  {auto rr=__builtin_amdgcn_permlane32_swap(__float_as_uint(l_reg),__float_as_uint(l_reg),false,false);l_reg=__uint_as_float(rr[0])+__uint_as_float(rr[1]);}
  if(hi==0)wsf[32+r32]=l_reg;asm volatile("s_waitcnt lgkmcnt(0)":::"memory");
  float rli[16];
  #pragma unroll
  for(int r=0;r<16;++r)rli[r]=__builtin_amdgcn_rcpf(wsf[32+crow(r,hi)]);
  bf16*Ow=O+(rowbase+q0+wid*QBLK)*DM+h*D;
  { bf16*stg=(bf16*)(shm+LDS_OST)+wid*2048;
    #pragma unroll
    for(int r=0;r<16;++r){const int orow=crow(r,hi);
      #pragma unroll
      for(int d0=0;d0<2;++d0)stg[orow*64+d0*32+r32]=__float2bfloat16(o[d0][r]*rli[r]);}
    asm volatile("s_waitcnt lgkmcnt(0)":::"memory");
    #pragma unroll
    for(int i=0;i<4;++i){const int row=i*8+(lane>>3),ch=lane&7; const u32x4 v=*(const u32x4*)(stg+row*64+ch*8); ATTN_STORE16(Ow+(long)row*DM+ch*8,v);} }
  asm volatile("s_waitcnt lgkmcnt(0)\n\ts_barrier":::"memory");
  #undef DMA_K
  #undef DMA_V
  #undef CMASK
  #undef MPF
  #undef MLOAD
  #undef MSEL
  #undef MAPPLY
  #undef START
  #undef RESC
  #undef ROT
}
constexpr int ATTN_LDS_BYTES=LDS_BYTES;
struct AttnTensors { const bf16* Q; const bf16* K; const bf16* V; bf16* O; const unsigned long long* MT; int wave; };
struct AttnUnit { int bh; int qb; };
struct StaticOrder {
  int vcu,G;
  __device__ __forceinline__ explicit StaticOrder(int grid,int block):vcu((grid%8==0)?(block%8)*(grid/8)+block/8:block),G(grid){}
  __device__ __forceinline__ bool next(int i,AttnUnit&u)const{ const int p=vcu+(i>>1)*G; if(p>=256)return false; const int s=p&31; u.bh=p>>5; u.qb=(i&1)?63-s:s; return true; }
  __device__ __forceinline__ void a_ready(const AttnUnit&)const{}
  __device__ __forceinline__ void done(const AttnUnit&)const{}
};
template<class Sched,int THRL=8> __device__ __forceinline__ void attn_phase(char*lds,const AttnTensors&T,const Sched&S){
  AttnUnit u;
  for(int i=0;S.next(i,u);++i){ S.a_ready(u); attn_unit<THRL>(u.bh/NHEAD,u.bh%NHEAD,u.qb,T.Q,T.K,T.V,T.O,T.MT,T.wave,lds); S.done(u); }
}
#undef SBAR
#undef WAIT_BAR
}


namespace gm {
template <int NSEG_> struct ProbDense {
    static constexpr int NSEG = NSEG_; static constexpr bool GATHER = false;
    const char* A0; const char* A1; const char* A2; const char* Bt; int M, N, K, lda, G, c, wgm;
    __device__ __forceinline__ bool next(int i, UnitX& u) const {
        int pm, pn; if (!static_unit((long)i * G + c, M / BM, N / BM, wgm, pm, pn)) return false;
        u.pm = pm; u.pn = pn; u.e = 0; u.blk = 0; u.nvalid = BM; u.rows = nullptr;
        const size_t ra = (size_t)pm * BM * lda * 2;
        u.A0 = A0 + ra; u.A1 = (NSEG_ == 3) ? A1 + ra : nullptr; u.A2 = (NSEG_ == 3) ? A2 + ra : nullptr; u.B = Bt + (size_t)pn * BM * K * 2; return true;
    }
};
template <bool UP> struct ProbMoe {
    static constexpr int NSEG = 1; static constexpr bool GATHER = UP;
    const char* A; const char* W; const int* toks; int K, lda, G, c; const LAS int* tl;
    __device__ __forceinline__ bool next(int i, UnitX& u) const {
        const long L = (long)i * G + c; const int T = tl[NEXP]; if (L >= (long)T * 4) return false;
        const int j = (int)(L >> 2), pn = (int)(L & 3); int e = 0;
#pragma unroll
        for (int k = 1; k < NEXP; ++k) e += (j >= tl[k]) ? 1 : 0;
        const int blk = j - tl[e]; { const int rem = tl[17 + e] - blk * BM; u.nvalid = rem < BM ? rem : BM; }
        u.pm = j; u.pn = pn; u.e = e; u.blk = blk; u.A1 = nullptr; u.A2 = nullptr;
        if (UP) { u.A0 = A; u.rows = toks + (size_t)e * CAPE + blk * BM; u.B = W + ((size_t)e * 1024 + (size_t)pn * BM) * 1024 * 2; }
        else    { u.A0 = A + (size_t)j * BM * 512 * 2; u.rows = nullptr; u.B = W + ((size_t)e * 1024 + (size_t)pn * BM) * 512 * 2; }
        return true;
    }
};

struct EpiProj {
    static constexpr bool PERM = true, HAS_MID = false;
    unsigned char* ws; const float* bias;
    __device__ __forceinline__ void operator()(const f32x4 (&acc)[2][2][4][2], const UnitX& u, int wr, int wc, int fr, int fq) const {
        asm volatile("" : "+v"(fr), "+v"(fq));
        const int pn = u.pn, row0 = u.pm * BM + wr * 64 + fr, cw = wc * 32 + 8 * fq, bcol0 = pn * BM + cw;
        f32x4 bv[2][2];
#pragma unroll
        for (int bj = 0; bj < 2; ++bj)
#pragma unroll
            for (int n = 0; n < 2; ++n) bv[bj][n] = *(const f32x4*)(bias + bcol0 + bj * HALF + 4 * n);
        if (pn >= 12 && pn < 24) {
#pragma unroll
            for (int ai = 0; ai < 2; ++ai)
#pragma unroll
                for (int m = 0; m < 4; ++m) { bf16_t* rowp = (bf16_t*)(ws + WS_GATE) + (size_t)(row0 + ai * HALF + m * 16) * 3072 + (pn - 12) * BM + cw;
#pragma unroll
                    for (int bj = 0; bj < 2; ++bj) { f32x4 v0 = acc[ai][bj][m][0] + bv[bj][0], v1 = acc[ai][bj][m][1] + bv[bj][1];
#pragma unroll
                        for (int j = 0; j < 4; ++j) { v0[j] = __builtin_amdgcn_rcpf(1.0f + __builtin_amdgcn_exp2f(-LOG2E * v0[j])); v1[j] = __builtin_amdgcn_rcpf(1.0f + __builtin_amdgcn_exp2f(-LOG2E * v1[j])); }
                        u32x4 w; w.x = cvt_pk_bf16(v0[0], v0[1]); w.y = cvt_pk_bf16(v0[2], v0[3]); w.z = cvt_pk_bf16(v1[0], v1[1]); w.w = cvt_pk_bf16(v1[2], v1[3]);
                        *(u32x4*)(rowp + bj * HALF) = w; } }
        } else if (pn < 2 || pn == 6 || pn == 7 || pn == 10 || pn == 11) {
            bf16_t* base = (bf16_t*)(ws + WS_PU + (size_t)(pn >> 1) * (16 * MiB)); const float sc = (pn >= 10) ? MQ_SCALE : 1.0f;
#pragma unroll
            for (int ai = 0; ai < 2; ++ai)
#pragma unroll
                for (int m = 0; m < 4; ++m) { bf16_t* rowp = base + (size_t)(row0 + ai * HALF + m * 16) * 512 + (pn & 1) * BM + cw;
#pragma unroll
                    for (int bj = 0; bj < 2; ++bj) { const f32x4 v0 = (acc[ai][bj][m][0] + bv[bj][0]) * sc, v1 = (acc[ai][bj][m][1] + bv[bj][1]) * sc;
                        u32x4 w; w.x = cvt_pk_bf16(v0[0], v0[1]); w.y = cvt_pk_bf16(v0[2], v0[3]); w.z = cvt_pk_bf16(v1[0], v1[1]); w.w = cvt_pk_bf16(v1[2], v1[3]);
                        *(u32x4*)(rowp + bj * HALF) = w; } }
        } else if (pn < 10) {
            bf16_t* base = (bf16_t*)(ws + WS_PU + (size_t)(pn >> 1) * (16 * MiB)); const float sc = (pn < 4) ? Q_SCALE : ((pn < 6) ? 1.0f : IQ_SCALE); const int g = (wc & 1) * 4 + fq;
            const float* rcos = (const float*)(ws + WS_RCOS); const float* rsin = (const float*)(ws + WS_RSIN);
#pragma unroll
            for (int ai = 0; ai < 2; ++ai)
#pragma unroll
                for (int m = 0; m < 4; ++m) { const int row = row0 + ai * HALF + m * 16; bf16_t* rowp = base + (size_t)row * 512 + (pn & 1) * BM + cw;
                    f32x4 cs = *(const f32x4*)(rcos + (size_t)row * 32 + 4 * g), sn = *(const f32x4*)(rsin + (size_t)row * 32 + 4 * g);
                    asm volatile("" : "+v"(cs), "+v"(sn));
#pragma unroll
                    for (int bj = 0; bj < 2; ++bj) { const f32x4 x1 = (acc[ai][bj][m][0] + bv[bj][0]) * sc, x2 = (acc[ai][bj][m][1] + bv[bj][1]) * sc;
                        const f32x4 o1 = x1 * cs - x2 * sn, o2 = x2 * cs + x1 * sn;
                        u32x4 w; w.x = cvt_pk_bf16(o1[0], o1[1]); w.y = cvt_pk_bf16(o1[2], o1[3]); w.z = cvt_pk_bf16(o2[0], o2[1]); w.w = cvt_pk_bf16(o2[2], o2[3]);
                        *(u32x4*)(rowp + bj * HALF) = w; }
                    asm volatile("" ::: "memory"); }
        } else {
            const float* rcos = (const float*)(ws + WS_RCOS); const float* rsin = (const float*)(ws + WS_RSIN); bf16_t* ik = (bf16_t*)(ws + WS_IK); float* iw = (float*)(ws + WS_IW);
            if (wc < 2) { const int g = (wc & 1) * 4 + fq;
#pragma unroll
                for (int ai = 0; ai < 2; ++ai)
#pragma unroll
                    for (int m = 0; m < 4; ++m) { const int row = row0 + ai * HALF + m * 16;
                        const f32x4 cs = *(const f32x4*)(rcos + (size_t)row * 32 + 4 * g), sn = *(const f32x4*)(rsin + (size_t)row * 32 + 4 * g);
                        const f32x4 x1 = acc[ai][0][m][0] + bv[0][0], x2 = acc[ai][0][m][1] + bv[0][1];
                        const f32x4 o1 = x1 * cs - x2 * sn, o2 = x2 * cs + x1 * sn;
                        u32x4 w; w.x = cvt_pk_bf16(o1[0], o1[1]); w.y = cvt_pk_bf16(o1[2], o1[3]); w.z = cvt_pk_bf16(o2[0], o2[1]); w.w = cvt_pk_bf16(o2[2], o2[3]);
                        *(u32x4*)(ik + (size_t)row * 64 + cw) = w; }
            } else if (wc == 2 && fq == 0) {
#pragma unroll
                for (int ai = 0; ai < 2; ++ai)
#pragma unroll
                    for (int m = 0; m < 4; ++m) { const int row = row0 + ai * HALF + m * 16;
                        *(f32x4*)(iw + (size_t)row * 8) = (acc[ai][0][m][0] + bv[0][0]) * IW_SCALE; *(f32x4*)(iw + (size_t)row * 8 + 4) = (acc[ai][0][m][1] + bv[0][1]) * IW_SCALE; }
            }
        }
    }
};

struct EpiMerge {
    static constexpr bool PERM = true, HAS_MID = true;
    const bf16_t* gate; bf16_t* out;
    __device__ __forceinline__ void mid(f32x4 (&acc)[2][2][4][2], const UnitX& u, int t, int wr, int wc, int fr, int fq) const {
        asm volatile("" : "+v"(fr), "+v"(fq));
        const int na = (t == 8) ? 0 : 1, row0 = u.pm * BM + wr * 64 + fr, col0 = u.pn * BM + wc * 32 + 8 * fq;
#pragma unroll
        for (int ai = 0; ai < 2; ++ai)
#pragma unroll
            for (int m = 0; m < 4; ++m) { const bf16_t* gp = gate + (size_t)(row0 + ai * HALF + m * 16) * 3072 + na * 1024 + col0;
#pragma unroll
                for (int bj = 0; bj < 2; ++bj) { const u32x4 a = *(const u32x4*)(gp + bj * HALF), b = *(const u32x4*)(gp + 1024 + bj * HALF);
                    f32x4 r0, r1;
                    r0[0] = bf_lo(a.x) * __builtin_amdgcn_rcpf(fmaxf(bf_lo(b.x), 1e-30f)); r0[1] = bf_hi(a.x) * __builtin_amdgcn_rcpf(fmaxf(bf_hi(b.x), 1e-30f));
                    r0[2] = bf_lo(a.y) * __builtin_amdgcn_rcpf(fmaxf(bf_lo(b.y), 1e-30f)); r0[3] = bf_hi(a.y) * __builtin_amdgcn_rcpf(fmaxf(bf_hi(b.y), 1e-30f));
                    r1[0] = bf_lo(a.z) * __builtin_amdgcn_rcpf(fmaxf(bf_lo(b.z), 1e-30f)); r1[1] = bf_hi(a.z) * __builtin_amdgcn_rcpf(fmaxf(bf_hi(b.z), 1e-30f));
                    r1[2] = bf_lo(a.w) * __builtin_amdgcn_rcpf(fmaxf(bf_lo(b.w), 1e-30f)); r1[3] = bf_hi(a.w) * __builtin_amdgcn_rcpf(fmaxf(bf_hi(b.w), 1e-30f));
                    acc[ai][bj][m][0] *= r0; acc[ai][bj][m][1] *= r1; }
                if (m == 3) asm volatile("" ::: "memory"); }
    }
    __device__ __forceinline__ void operator()(const f32x4 (&acc)[2][2][4][2], const UnitX& u, int wr, int wc, int fr, int fq) const {
        asm volatile("" : "+v"(fr), "+v"(fq));
        const int row0 = u.pm * BM + wr * 64 + fr, col0 = u.pn * BM + wc * 32 + 8 * fq;
#pragma unroll
        for (int ai = 0; ai < 2; ++ai)
#pragma unroll
            for (int m = 0; m < 4; ++m) { const int row = row0 + ai * HALF + m * 16; const bf16_t* gp = gate + (size_t)row * 3072 + 2048 + col0; bf16_t* op = out + (size_t)row * 1024 + col0;
#pragma unroll
                for (int bj = 0; bj < 2; ++bj) { const u32x4 a = *(const u32x4*)(gp + bj * HALF);
                    const f32x4 v0 = acc[ai][bj][m][0] * (f32x4){bf_lo(a.x), bf_hi(a.x), bf_lo(a.y), bf_hi(a.y)}, v1 = acc[ai][bj][m][1] * (f32x4){bf_lo(a.z), bf_hi(a.z), bf_lo(a.w), bf_hi(a.w)};
                    u32x4 w; w.x = cvt_pk_bf16(v0[0], v0[1]); w.y = cvt_pk_bf16(v0[2], v0[3]); w.z = cvt_pk_bf16(v1[0], v1[1]); w.w = cvt_pk_bf16(v1[2], v1[3]);
                    *(u32x4*)(op + bj * HALF) = w; }
                if (m & 1) asm volatile("" ::: "memory"); }
    }
};

struct EpiMemKV {
    static constexpr bool PERM = false, HAS_MID = false;
    bf16_t* mk; bf16_t* mvt;
    __device__ __forceinline__ void operator()(const f32x4 (&acc)[2][2][4][2], const UnitX& u, int wr, int wc, int fr, int fq) const {
        asm volatile("" : "+v"(fr), "+v"(fq));
        const int row0 = wr * 64 + fr, col0 = u.pn * BM + wc * 32 + 4 * fq;
#pragma unroll
        for (int ai = 0; ai < 2; ++ai)
#pragma unroll
            for (int m = 0; m < 4; ++m) { const int row = row0 + ai * HALF + m * 16, mm = row & 15, slot = (row & ~15) + 8 * ((mm >> 2) & 1) + (mm & 3) + 4 * (mm >> 3);
#pragma unroll
                for (int bj = 0; bj < 2; ++bj)
#pragma unroll
                    for (int n = 0; n < 2; ++n) { const int c = col0 + bj * HALF + n * 16, l = c >> 10, cc = c & 1023; const f32x4 v = acc[ai][bj][m][n];
                        if (cc < 512) { const int h = cc >> 7, d = cc & 127;
                            *(unsigned long long*)(mk + ((size_t)(l * 4 + h) * 256 + row) * 128 + d) = (unsigned long long)cvt_pk_bf16(v[0], v[1]) | ((unsigned long long)cvt_pk_bf16(v[2], v[3]) << 32);
                        } else { const int h = (cc - 512) >> 7, d = (cc - 512) & 127; bf16_t* o = mvt + ((size_t)(l * 4 + h) * 128 + d) * 256 + slot; const unsigned w0 = cvt_pk_bf16(v[0], v[1]), w1 = cvt_pk_bf16(v[2], v[3]);
                            o[0] = (bf16_t)(w0 & 0xffffu); o[256] = (bf16_t)(w0 >> 16); o[512] = (bf16_t)(w1 & 0xffffu); o[768] = (bf16_t)(w1 >> 16); } } }
    }
};
struct EpiRes {
    static constexpr bool PERM = false, HAS_MID = false;
    const float* xin; float* out;
    __device__ __forceinline__ void operator()(const f32x4 (&acc)[2][2][4][2], const UnitX& u, int wr, int wc, int fr, int fq) const {
        asm volatile("" : "+v"(fr), "+v"(fq));
        const int row0 = u.pm * BM + wr * 64 + fr, col0 = u.pn * BM + wc * 32 + 4 * fq;
#pragma unroll
        for (int ai = 0; ai < 2; ++ai)
#pragma unroll
            for (int m = 0; m < 4; ++m) { const size_t off = (size_t)(row0 + ai * HALF + m * 16) * D + col0;
#pragma unroll
                for (int bj = 0; bj < 2; ++bj)
#pragma unroll
                    for (int n = 0; n < 2; ++n) { const f32x4 xv = *(const f32x4*)(xin + off + bj * HALF + n * 16); *(f32x4*)(out + off + bj * HALF + n * 16) = xv * DN_ALPHA + acc[ai][bj][m][n]; }
                if (m & 1) asm volatile("" ::: "memory"); }
    }
};

struct EpiSwiglu {
    static constexpr bool PERM = true, HAS_MID = false;
    bf16_t* h;
    __device__ __forceinline__ void operator()(const f32x4 (&acc)[2][2][4][2], const UnitX& u, int wr, int wc, int fr, int fq) const {
        asm volatile("" : "+v"(fr), "+v"(fq));
        const int row0 = u.pm * BM + wr * 64 + fr, col0 = u.pn * HALF + wc * 32 + 8 * fq;
#pragma unroll
        for (int ai = 0; ai < 2; ++ai)
#pragma unroll
            for (int m = 0; m < 4; ++m) { f32x4 o[2];
#pragma unroll
                for (int n = 0; n < 2; ++n)
#pragma unroll
                    for (int j = 0; j < 4; ++j) { const float a = acc[ai][0][m][n][j]; o[n][j] = a * __builtin_amdgcn_rcpf(1.0f + __builtin_amdgcn_exp2f(-LOG2E * a)) * acc[ai][1][m][n][j]; }
                u32x4 w; w.x = cvt_pk_bf16(o[0][0], o[0][1]); w.y = cvt_pk_bf16(o[0][2], o[0][3]); w.z = cvt_pk_bf16(o[1][0], o[1][1]); w.w = cvt_pk_bf16(o[1][2], o[1][3]);
                *(u32x4*)(h + (size_t)(row0 + ai * HALF + m * 16) * 512 + col0) = w; }
    }
};

struct EpiMoeOut {
    static constexpr bool PERM = true, HAS_MID = false;
    const unsigned* toks; const float* gl; const LAS int* cnt; bf16_t* o2;
    __device__ __forceinline__ void operator()(const f32x4 (&acc)[2][2][4][2], const UnitX& u, int wr, int wc, int fr, int fq) const {
        asm volatile("" : "+v"(fr), "+v"(fq));
        const int n_e = cnt[u.e], col0 = u.pn * BM + wc * 32 + 8 * fq;
        unsigned ents[2][4]; float gws[2][4];
#pragma unroll
        for (int ai = 0; ai < 2; ++ai)
#pragma unroll
            for (int m = 0; m < 4; ++m) { const int pos = u.blk * BM + ai * HALF + wr * 64 + m * 16 + fr; const bool ok = pos < n_e;
                ents[ai][m] = ok ? toks[(size_t)u.e * CAPE + pos] : 0u; gws[ai][m] = ok ? gl[(size_t)u.e * CAPE + pos] : 0.f; }
#pragma unroll
        for (int ai = 0; ai < 2; ++ai)
#pragma unroll
            for (int m = 0; m < 4; ++m) { const int pos = u.blk * BM + ai * HALF + wr * 64 + m * 16 + fr;
                if (pos < n_e) { const unsigned ent = ents[ai][m]; const float gw = gws[ai][m];
                    bf16_t* op = o2 + (size_t)ent * D + col0;
#pragma unroll
                    for (int bj = 0; bj < 2; ++bj) { const f32x4 v0 = acc[ai][bj][m][0] * gw, v1 = acc[ai][bj][m][1] * gw;
                        u32x4 w; w.x = cvt_pk_bf16(v0[0], v0[1]); w.y = cvt_pk_bf16(v0[2], v0[3]); w.z = cvt_pk_bf16(v1[0], v1[1]); w.w = cvt_pk_bf16(v1[2], v1[3]);
                        *(u32x4*)(op + bj * HALF) = w; } } }
    }
};
}
#define XB_TMO      128
#define XB_XCNT(j)  (256  + 64 * (j))
#define XB_XSUB(j)  (1280 + 64 * (j))
#define XB_XGEN(j)  (2304 + 64 * (j))
#define XB_TOP      3328
#define XB_TOPGEN   3392
#define XCD_BAR_WORDS 3456
#define XB_SPIN_CAP (1u << 18)

__device__ __forceinline__ unsigned xb_ld(unsigned* p)              { return __hip_atomic_load(p, __ATOMIC_RELAXED, __HIP_MEMORY_SCOPE_AGENT); }
__device__ __forceinline__ unsigned xb_add(unsigned* p, unsigned v) { return __hip_atomic_fetch_add(p, v, __ATOMIC_RELAXED, __HIP_MEMORY_SCOPE_AGENT); }
__device__ __forceinline__ unsigned xb_xcc_id() { return (unsigned)__builtin_amdgcn_s_getreg((3 << 11) | 20) & 0xFu; }
#define XB_SPIN(cond, bar) do { unsigned _sp = 0; while (cond) { __builtin_amdgcn_s_sleep(1); \
    if ((++_sp & 255u) == 0u) { if (xb_ld(&(bar)[XB_TMO])) break; if (_sp > XB_SPIN_CAP) { atomicAdd(&(bar)[XB_TMO], 1u); break; } } } } while (0)

struct XcdBarrier {
    unsigned* bar; unsigned x;
    volatile LAS unsigned* st;
    int w;
};

__device__ __forceinline__ XcdBarrier xcd_barrier_post(unsigned* bar, volatile LAS unsigned* st) {
    XcdBarrier b; b.bar = bar; b.x = xb_xcc_id(); b.st = st; b.w = (int)(threadIdx.x >> 6);
    if (threadIdx.x == 0) (void)xb_add(&bar[XB_XCNT(b.x)], 1u);
    return b;
}
__device__ __forceinline__ void xcd_barrier_complete(unsigned* bar, unsigned x, unsigned& nloc, unsigned& nx) {
    const unsigned G = gridDim.x * gridDim.y * gridDim.z;
    unsigned sum, cnt, mine, sp = 0u;
    for (;;) {
        sum = 0u; cnt = 0u; mine = 0u;
#pragma unroll
        for (unsigned j = 0; j < 16; ++j) { const unsigned c = xb_ld(&bar[XB_XCNT(j)]); sum += c; cnt += (c > 0u) ? 1u : 0u; mine = (j == x) ? c : mine; }
        if (sum == G) break;
        __builtin_amdgcn_s_sleep(1);
        if ((++sp & 255u) == 0u) { if (xb_ld(&bar[XB_TMO])) break; if (sp > XB_SPIN_CAP) { atomicAdd(&bar[XB_TMO], 1u); break; } }
    }
    nloc = mine > 0u ? mine : 1u; nx = cnt > 0u ? cnt : 1u;
}

__device__ __forceinline__ void xcd_barrier(const XcdBarrier& b) {
    asm volatile("s_waitcnt vmcnt(0)" ::: "memory");
    __syncthreads();
    if (b.w == 0 && gm::gm_lane_id() == 0) {
        unsigned* bar = b.bar;
        __builtin_amdgcn_s_waitcnt(0);
        unsigned nloc = b.st[0], nx = b.st[1];
        if (nloc == 0u) { xcd_barrier_complete(bar, b.x, nloc, nx); b.st[0] = nloc; b.st[1] = nx; }
        const unsigned old = xb_add(&bar[XB_XSUB(b.x)], 1u);
        const unsigned gen = old / nloc;
        if (old + 1u == (gen + 1u) * nloc) {
            __builtin_amdgcn_fence(__ATOMIC_RELEASE, "agent");
            asm volatile("s_waitcnt vmcnt(0)" ::: "memory");
            const unsigned og = xb_add(&bar[XB_TOP], 1u);
            const unsigned tg = og / nx;
            if (og + 1u == (tg + 1u) * nx) xb_add(&bar[XB_TOPGEN], 1u);
            else XB_SPIN(xb_ld(&bar[XB_TOPGEN]) == tg, bar);
            __builtin_amdgcn_fence(__ATOMIC_ACQUIRE, "agent");
            xb_add(&bar[XB_XGEN(b.x)], 1u);
            asm volatile("s_waitcnt vmcnt(0)" ::: "memory");
        } else {
            XB_SPIN(xb_ld(&bar[XB_XGEN(b.x)]) == gen, bar);
            __builtin_amdgcn_fence(__ATOMIC_ACQUIRE, "agent");
            asm volatile("s_waitcnt vmcnt(0)" ::: "memory");
        }
    }
    __syncthreads();
}

namespace ix {
typedef float f32x2 __attribute__((ext_vector_type(2)));
typedef __bf16 bf16v2 __attribute__((ext_vector_type(2)));
typedef short s16x2 __attribute__((ext_vector_type(2)));
__device__ __forceinline__ unsigned relu_pk_bf16(float a, float b) {
    const f32x2 v = {a, b}; const bf16v2 h = __builtin_convertvector(v, bf16v2);
    s16x2 s = __builtin_bit_cast(s16x2, h); const s16x2 z = {0, 0}; s = __builtin_elementwise_max(s, z);
    return __builtin_bit_cast(unsigned, s);
}
constexpr int CAP = 704, HI_WATER = 640, KEEP = 272, GT = 4, NK = CAP / 64;
constexpr int L_CAND = 0, L_IK = 32 * CAP * 4, L_IMG = L_IK, L_HIST = L_IK + 2 * GT * 8192, L_END = L_HIST + NWAVES * 512;
static_assert(L_END <= LDSCTL_OFF, "indexer LDS map");
__device__ __forceinline__ unsigned pack_key2(float s, unsigned idxpart) { const unsigned u = __float_as_uint(s); const unsigned m = (unsigned)((int)u >> 31) | 0x80000000u; return ((u ^ m) & 0xFFFFC000u) | idxpart; }
__device__ __forceinline__ unsigned pack_key(float s, int keyidx) { unsigned u = __float_as_uint(s); u = (u & 0x80000000u) ? ~u : (u | 0x80000000u); return (u & 0xFFFFC000u) | (unsigned)(16383 - keyidx); }
__device__ __forceinline__ int filter_keys(LAS unsigned* cq, int n, const unsigned (&k)[NK], unsigned T, int lane) {
    int base = 0;
#pragma unroll
    for (int j = 0; j < NK; ++j) { const bool keep = (lane + 64 * j < n) && (k[j] >= T); const unsigned long long bal = __ballot(keep);
        const int pos = base + (int)__builtin_amdgcn_mbcnt_hi((unsigned)(bal >> 32), __builtin_amdgcn_mbcnt_lo((unsigned)bal, 0u));
        if (keep) cq[pos] = k[j];
        base += __popcll(bal); }
    asm volatile("s_waitcnt lgkmcnt(0)" ::: "memory");
    return base;
}
__device__ __forceinline__ unsigned exact_threshold(const unsigned (&k)[NK], int n, LAS unsigned* hist, int lane) {
    unsigned prefix = 0u, T = 0u; int need = 256; bool done = false;
#pragma unroll 1
    for (int pass = 0; pass < 4 && !done; ++pass) {
        const int sh = 24 - 8 * pass;
        *(LAS unsigned long long*)(hist + 2 * lane) = 0ull;
        asm volatile("s_waitcnt lgkmcnt(0)" ::: "memory");
#pragma unroll
        for (int j = 0; j < NK; ++j) { const bool in = (lane + 64 * j < n) && ((pass == 0) || ((k[j] >> ((sh + 8) & 31)) == prefix)); const unsigned d_ = (k[j] >> sh) & 255u;
            if (in) __hip_atomic_fetch_add(hist + (d_ >> 1), (d_ & 1u) ? 0x10000u : 1u, __ATOMIC_RELAXED, __HIP_MEMORY_SCOPE_WORKGROUP); }
        asm volatile("s_waitcnt lgkmcnt(0)" ::: "memory");
        const unsigned long long cw_ = *(const LAS unsigned long long*)(hist + 2 * lane); v4u c; c.x = (unsigned)cw_ & 0xffffu; c.y = ((unsigned)cw_) >> 16; c.z = (unsigned)(cw_ >> 32) & 0xffffu; c.w = (unsigned)(cw_ >> 48);
        asm volatile("s_waitcnt lgkmcnt(0)" ::: "memory");
        const int s = (int)(c.x + c.y + c.z + c.w); int x = s;
#pragma unroll
        for (int o = 1; o < 64; o <<= 1) { const int y = __shfl_down(x, o); if (lane + o < 64) x += y; }
        const int above = x - s; const bool here = (above < need) && (x >= need);
        int b, ab, cb;
        { const int a3 = above, a2 = a3 + (int)c.w, a1 = a2 + (int)c.z, a0 = a1 + (int)c.y;
          if (a2 >= need) { b = 3; ab = a3; cb = (int)c.w; } else if (a1 >= need) { b = 2; ab = a2; cb = (int)c.z; } else if (a0 >= need) { b = 1; ab = a1; cb = (int)c.y; } else { b = 0; ab = a0; cb = (int)c.x; } }
        const unsigned long long hb = __ballot(here); const int src = hb ? (__ffsll((long long)hb) - 1) : 0;
        const int bg = __shfl(4 * lane + b, src); ab = __shfl(ab, src); cb = __shfl(cb, src);
        prefix = (prefix << 8) | (unsigned)bg; need -= ab; T = prefix << sh;
        if (cb == need) done = true;
    }
    return T;
}
__device__ __forceinline__ unsigned compact_keys(LAS unsigned* cq, int& n, bool final, LAS unsigned* hist, int lane) {
    unsigned k[NK];
#pragma unroll
    for (int j = 0; j < NK; ++j) { const int idx = lane + 64 * j; k[j] = (idx < n) ? cq[idx] : 0u; }
    unsigned T = 0u; bool exact = final;
    if (!final) {
        const int jj = lane % NK; unsigned smp = k[0];
#pragma unroll
        for (int j = 1; j < NK; ++j) smp = (jj == j) ? k[j] : smp;
        int rank = 0;
#pragma unroll
        for (int i = 0; i < 64; ++i) { const unsigned o = (unsigned)__builtin_amdgcn_readlane((int)smp, i); rank += (o > smp) ? 1 : 0; }
        int want = (64 * KEEP) / n, cnt = 0;
#pragma unroll 1
        for (int it = 0; it < 8; ++it) {
            const unsigned long long hb = __ballot(rank == want && smp != 0u);
            T = hb ? (unsigned)__builtin_amdgcn_readlane((int)smp, __ffsll((long long)hb) - 1) : 0u;
            cnt = 0;
#pragma unroll
            for (int j = 0; j < NK; ++j) cnt += __popcll(__ballot((lane + 64 * j < n) && (k[j] >= T)));
            if (cnt >= 256) break;
            want += 8; if (want > 63 || it == 6) { want = 64; }
        }
        exact = cnt > HI_WATER - 64;
    }
    if (exact) T = exact_threshold(k, n, hist, lane);
    n = filter_keys(cq, n, k, T, lane);
    return T;
}
__device__ __forceinline__ void indexer_unit(int g, const bf16* IQ, const bf16* IK, const float* IW, unsigned long long* MT, LAS unsigned char* lds, int tid, int lane, int wid, bool dry = false) {
    const int hi = lane >> 5, c31 = lane & 31;
    const int q0 = 32 * g, ntile = (g >> 1) + 1, ntimg = 4 * ((g >> 3) + 1), ngrp = (ntile + GT - 1) / GT;
    LAS unsigned* cand = (LAS unsigned*)(lds + L_CAND) + (4 * wid) * CAP;
    LAS unsigned* img = (LAS unsigned*)(lds + L_IMG);
    LAS unsigned* hist = (LAS unsigned*)(lds + L_HIST) + wid * 128;
    bf16x8 af[4]; { const bf16* ap = IQ + (size_t)(q0 + 4 * wid) * 512 + c31 * 64 + 8 * hi;
#pragma unroll
        for (int s = 0; s < 4; ++s) af[s] = *(const bf16x8*)(ap + 16 * s); }
    f32x4 wv[4];
#pragma unroll
    for (int ql = 0; ql < 4; ++ql) wv[ql] = *(const f32x4*)(IW + (size_t)(q0 + 4 * wid + ql) * 8 + 4 * hi);
    bf16x8 a2[2];
    { unsigned wh[4][2], wl[4][2];
#pragma unroll
        for (int ql = 0; ql < 4; ++ql) {
#pragma unroll
            for (int e = 0; e < 2; ++e) { const float x0 = wv[ql][2 * e], x1 = wv[ql][2 * e + 1]; const unsigned h0 = f2bf(x0), h1 = f2bf(x1);
                wh[ql][e] = h0 | (h1 << 16); wl[ql][e] = pk2(x0 - __uint_as_float(h0 << 16), x1 - __uint_as_float(h1 << 16)); } }
        const int m = c31; v4u u0 = {0u, 0u, 0u, 0u}, u1 = {0u, 0u, 0u, 0u};
        if (m == 0) { u0[0] = wh[0][0]; u0[1] = wh[0][1]; } if (m == 2) { u0[0] = wl[0][0]; u0[1] = wl[0][1]; }
        if (m == 1) { u0[2] = wh[1][0]; u0[3] = wh[1][1]; } if (m == 3) { u0[2] = wl[1][0]; u0[3] = wl[1][1]; }
        if (m == 4) { u1[0] = wh[2][0]; u1[1] = wh[2][1]; } if (m == 6) { u1[0] = wl[2][0]; u1[1] = wl[2][1]; }
        if (m == 5) { u1[2] = wh[3][0]; u1[3] = wh[3][1]; } if (m == 7) { u1[2] = wl[3][0]; u1[3] = wl[3][1]; }
        a2[0] = __builtin_bit_cast(bf16x8, u0); a2[1] = __builtin_bit_cast(bf16x8, u1); }
    int cnt0 = 0, cnt1 = 0, cnt2 = 0, cnt3 = 0; unsigned T0 = 0u, T1 = 0u, T2 = 0u, T3 = 0u;
    const GAS unsigned char* ikb = (const GAS unsigned char*)IK; const unsigned ikoff = (unsigned)tid * 16u;
    const unsigned stoff = (unsigned)((tid >> 3) * 128 + (((tid & 7) ^ ((tid >> 4) & 7)) * 16));
    v4u st[2];
#define IX_LD(TB) do { _Pragma("unroll") for (int i_ = 0; i_ < 2; ++i_) if ((TB) + i_ < ntile) st[i_] = *(const GAS v4u*)(ikb + (size_t)((TB) + i_) * 8192 + ikoff); } while (0)
#define IX_ST(TB, BUF, I0) do { _Pragma("unroll") for (int i_ = 0; i_ < 2; ++i_) if ((TB) + i_ < ntile) *(LAS v4u*)(lds + L_IK + (BUF) * (GT * 8192) + ((I0) + i_) * 8192 + stoff) = st[i_]; } while (0)
    IX_LD(0); IX_ST(0, 0, 0); IX_LD(2); IX_ST(2, 0, 2);
    __syncthreads();
    LAS unsigned* trash = hist + lane;
    const unsigned candb = (unsigned)__builtin_amdgcn_readfirstlane((int)(unsigned)(size_t)cand), trashb = (unsigned)(size_t)trash;
    const unsigned lidx = 16383u - (unsigned)lane;
    const LAS unsigned char* bbase = lds + L_IK + c31 * 128; const int sw = (c31 >> 1) & 7;
    int xo[4];
#pragma unroll
    for (int s = 0; s < 4; ++s) xo[s] = ((2 * s + hi) ^ sw) * 16;
    f32x16 dA0 = {}, dA1 = {}, dB0 = {}, dB1 = {};
#define IX_SB() __builtin_amdgcn_sched_barrier(0)
#define IX_MIX() do { if (IXMIXON) __builtin_amdgcn_sched_group_barrier(0x100, 8, 0); \
        _Pragma("unroll") for (int g_ = 0; g_ < 12; ++g_) if (IXMIXON) { __builtin_amdgcn_sched_group_barrier(0x008, 1, 0); __builtin_amdgcn_sched_group_barrier(0x006, 11, 0); } IX_SB(); } while (0)
#define IX_FR(TT, BUF, F) do { const LAS unsigned char* bt_ = bbase + (BUF) * (GT * 8192) + (TT) * 8192; \
        _Pragma("unroll") for (int s_ = 0; s_ < 4; ++s_) { F[s_] = *(const LAS bf16x8*)(bt_ + xo[s_]); F[4 + s_] = *(const LAS bf16x8*)(bt_ + 4096 + xo[s_]); } } while (0)
#define IX_MMA(F, D0, D1) do { _Pragma("unroll") for (int r_ = 0; r_ < 16; ++r_) { D0[r_] = 0.f; D1[r_] = 0.f; } \
        _Pragma("unroll") for (int s_ = 0; s_ < 4; ++s_) { D0 = __builtin_amdgcn_mfma_f32_32x32x16_bf16(af[s_], F[s_], D0, 0, 0, 0); D1 = __builtin_amdgcn_mfma_f32_32x32x16_bf16(af[s_], F[4 + s_], D1, 0, 0, 0); } } while (0)
#define IX_APPEND(SC, CNT, TQ, QI) do { const unsigned k32_ = pack_key2(SC, idxp_); const bool pass_ = k32_ >= (TQ); \
        const unsigned long long bal_ = __ballot(pass_); \
        unsigned sb_ = candb + 4u * (unsigned)((QI) * CAP + CNT); asm volatile("" : "+s"(sb_));     \
        const unsigned ad_ = sb_ + 4u * __builtin_amdgcn_mbcnt_hi((unsigned)(bal_ >> 32), __builtin_amdgcn_mbcnt_lo((unsigned)bal_, 0u)); \
        *(LAS unsigned*)(pass_ ? ad_ : trashb) = k32_;     \
        CNT += __popcll(bal_); } while (0)
#define IX_SUMS(D0, D1) do { sa0_ = D0[0] + D0[2]; sa1_ = D0[1] + D0[3]; sb0_ = D1[0] + D1[2]; sb1_ = D1[1] + D1[3]; } while (0)
#define IX_CVT1(D) do { v4u pa_, pb_; \
        _Pragma("unroll") for (int i_ = 0; i_ < 4; ++i_) { pa_[i_] = relu_pk_bf16(D[2 * i_], D[2 * i_ + 1]); pb_[i_] = relu_pk_bf16(D[8 + 2 * i_], D[9 + 2 * i_]); } \
        _Pragma("unroll") for (int r_ = 0; r_ < 16; ++r_) D[r_] = 0.f; \
        D = __builtin_amdgcn_mfma_f32_32x32x16_bf16(a2[0], __builtin_bit_cast(bf16x8, pa_), D, 0, 0, 0); D = __builtin_amdgcn_mfma_f32_32x32x16_bf16(a2[1], __builtin_bit_cast(bf16x8, pb_), D, 0, 0, 0); } while (0)
#define IX_CVT2(D0, D1) do { IX_CVT1(D0); IX_CVT1(D1); } while (0)
#define IX_APP(T) do { const bool ok_ = (unsigned)(T) < (unsigned)ntile; const unsigned idxp_ = lidx - 64u * (unsigned)(T);     \
        const auto r0_ = __builtin_amdgcn_permlane32_swap(__float_as_uint(sa0_), __float_as_uint(sb0_), false, false); \
        const auto r1_ = __builtin_amdgcn_permlane32_swap(__float_as_uint(sa1_), __float_as_uint(sb1_), false, false); \
        IX_APPEND(__uint_as_float(r0_[0]), cnt0, ok_ ? T0 : 0xFFFFFFFFu, 0); IX_APPEND(__uint_as_float(r1_[0]), cnt1, ok_ ? T1 : 0xFFFFFFFFu, 1); \
        IX_APPEND(__uint_as_float(r0_[1]), cnt2, ok_ ? T2 : 0xFFFFFFFFu, 2); IX_APPEND(__uint_as_float(r1_[1]), cnt3, ok_ ? T3 : 0xFFFFFFFFu, 3); } while (0)
#define IX_CUT(LIMIT, FINAL) do { asm volatile("" ::: "memory");     \
        _Pragma("unroll 1") for (;;) { const int q_ = (cnt0 > (LIMIT)) ? 0 : ((cnt1 > (LIMIT)) ? 1 : ((cnt2 > (LIMIT)) ? 2 : ((cnt3 > (LIMIT)) ? 3 : -1))); if (q_ < 0) break; \
            int n_ = (q_ == 0) ? cnt0 : ((q_ == 1) ? cnt1 : ((q_ == 2) ? cnt2 : cnt3)); const unsigned t_ = compact_keys(cand + q_ * CAP, n_, FINAL, hist, lane); \
            cnt0 = (q_ == 0) ? n_ : cnt0; cnt1 = (q_ == 1) ? n_ : cnt1; cnt2 = (q_ == 2) ? n_ : cnt2; cnt3 = (q_ == 3) ? n_ : cnt3; \
            const unsigned tu_ = (unsigned)__builtin_amdgcn_readfirstlane((int)t_); T0 = (q_ == 0) ? tu_ : T0; T1 = (q_ == 1) ? tu_ : T1; T2 = (q_ == 2) ? tu_ : T2; T3 = (q_ == 3) ? tu_ : T3; } } while (0)
#define IX_SLOT(U, X0, X1, Y0, Y1, FRNEXT) do { float sa0_, sa1_, sb0_, sb1_; IX_SUMS(X0, X1); IX_SB(); \
        IX_CVT2(Y0, Y1); IX_MMA(fA, X0, X1); FRNEXT; IX_APP((U) - 2); IX_MIX(); IX_CUT(HI_WATER, false); IX_SB(); } while (0)
    bf16x8 fA[8];
#pragma unroll 1
    for (int grp = 0; grp < ngrp; ++grp) {
        const int buf = grp & 1, t0 = grp * GT;
        IX_LD(t0 + GT);
        IX_FR(0, buf, fA); IX_SB();
        IX_SLOT(t0, dA0, dA1, dB0, dB1, IX_FR(1, buf, fA));
        IX_SLOT(t0 + 1, dB0, dB1, dA0, dA1, IX_FR(2, buf, fA));
        IX_ST(t0 + GT, buf ^ 1, 0); IX_LD(t0 + GT + 2);
        IX_SLOT(t0 + 2, dA0, dA1, dB0, dB1, IX_FR(3, buf, fA));
        IX_SLOT(t0 + 3, dB0, dB1, dA0, dA1, (void)0);
        IX_ST(t0 + GT + 2, buf ^ 1, 2);
        __syncthreads();
    }
    { const int u = ngrp * GT; float sa0_, sa1_, sb0_, sb1_;
      IX_SUMS(dA0, dA1); IX_SB(); IX_CVT2(dB0, dB1); IX_APP(u - 2); IX_SB(); IX_CUT(HI_WATER, false); IX_SB();
      IX_SUMS(dB0, dB1); IX_SB(); IX_APP(u - 1); IX_SB(); }
#undef IX_FR
#undef IX_LD
#undef IX_ST
#undef IX_SB
    if (dry) return;
    IX_CUT(256, true);
#undef IX_MMA
#undef IX_APPEND
#undef IX_SUMS
#undef IX_CVT2
#undef IX_CVT1
#undef IX_APP
#undef IX_SLOT
#undef IX_CUT
    v4u* dst = (v4u*)(MT + (size_t)g * 256 * 32);
#pragma unroll 1
    for (int qt = 0; qt * 64 < ntimg; ++qt) {
        for (int i = tid; i < 1024; i += NWAVES * 64) ((LAS v4u*)img)[i] = (v4u){0u, 0u, 0u, 0u};
        __syncthreads();
#pragma unroll
        for (int ql = 0; ql < 4; ++ql) { const int n = (ql == 0) ? cnt0 : ((ql == 1) ? cnt1 : ((ql == 2) ? cnt2 : cnt3));
            for (int idx = lane; idx < n; idx += 64) { const unsigned k32 = cand[ql * CAP + idx]; const int key = 16383 - (int)(k32 & 0x3FFFu), t = (key >> 6) - 64 * qt, kk = key & 63, c = kk & 31;
                if (t >= 0 && t < 64) { const int e = (c & 3) + 4 * (c >> 3) + 16 * (kk >> 5), dw = (t * 32 + e) * 2 + ((c >> 2) & 1);
                    __hip_atomic_fetch_or(img + dw, 1u << (4 * wid + ql), __ATOMIC_RELAXED, __HIP_MEMORY_SCOPE_WORKGROUP); } } }
        asm volatile("s_waitcnt lgkmcnt(0)" ::: "memory");
        __syncthreads();
        const int nq = (ntimg - 64 * qt < 64) ? (ntimg - 64 * qt) : 64;
        for (int i = tid; i < nq * 16; i += NWAVES * 64) dst[qt * 1024 + i] = ((const LAS v4u*)img)[i];
        __syncthreads();
    }
}
}

namespace ma {
constexpr int KROW = 272, VROW = 528, L_K = 0, L_V = 256 * KROW, L_WS = L_V + 128 * VROW, L_END = L_WS + NWAVES * 64 * 4;
__device__ __forceinline__ int crow(int r, int hi) { return (r & 3) + 8 * (r >> 2) + 4 * hi; }
__device__ __forceinline__ void mem_unit(int rowblk, int h, const bf16* mk, const bf16* mvt, const bf16* MQ, bf16* MO, LAS unsigned char* lds, int tid, int lane, int wid) {
    const int r32 = lane & 31, hi = lane >> 5;
#pragma unroll 1
    for (int h4 = 0; h4 < 2; ++h4) { v4u tk[4], tv[4];
#pragma unroll
        for (int k = 0; k < 4; ++k) { const int i = tid + 512 * (4 * h4 + k); tk[k] = *(const GAS v4u*)(mk + (size_t)(i >> 4) * 128 + (i & 15) * 8); tv[k] = *(const GAS v4u*)(mvt + (size_t)(i >> 5) * 256 + (i & 31) * 8); }
#pragma unroll
        for (int k = 0; k < 4; ++k) { const int i = tid + 512 * (4 * h4 + k); *(LAS v4u*)(lds + L_K + (i >> 4) * KROW + (i & 15) * 16) = tk[k]; *(LAS v4u*)(lds + L_V + (i >> 5) * VROW + (i & 31) * 16) = tv[k]; } }
    bf16x8 qr[8]; const bf16* qp = MQ + (size_t)(rowblk * 256 + 32 * wid + r32) * 512 + h * 128 + 8 * hi;
#pragma unroll
    for (int s = 0; s < 8; ++s) qr[s] = *(const bf16x8*)(qp + 16 * s);
    __syncthreads();
    LAS float* wsf = (LAS float*)(lds + L_WS) + wid * 64;
    float mrun = -1e30f, lrun = 0.f; f32x16 o[4];
#pragma unroll
    for (int db = 0; db < 4; ++db)
#pragma unroll
        for (int r = 0; r < 16; ++r) o[db][r] = 0.f;
#pragma unroll 1
    for (int jt = 0; jt < 4; ++jt) {
        f32x16 p0, p1;
#pragma unroll
        for (int r = 0; r < 16; ++r) { p0[r] = 0.f; p1[r] = 0.f; }
        const LAS unsigned char* kb = lds + L_K + (64 * jt + r32) * KROW + 16 * hi;
#pragma unroll
        for (int s = 0; s < 8; ++s) { const bf16x8 k0 = *(const LAS bf16x8*)(kb + 32 * s), k1 = *(const LAS bf16x8*)(kb + 32 * KROW + 32 * s);
            p0 = __builtin_amdgcn_mfma_f32_32x32x16_bf16(k0, qr[s], p0, 0, 0, 0); p1 = __builtin_amdgcn_mfma_f32_32x32x16_bf16(k1, qr[s], p1, 0, 0, 0); }
        float rm = fmaxf(p0[0], p1[0]);
#pragma unroll
        for (int r = 1; r < 16; ++r) rm = fmaxf(rm, fmaxf(p0[r], p1[r]));
        { const auto rr = __builtin_amdgcn_permlane32_swap(__float_as_uint(rm), __float_as_uint(rm), false, false); rm = fmaxf(__uint_as_float(rr[0]), __uint_as_float(rr[1])); }
        const float mn = fmaxf(mrun, rm), f = __builtin_amdgcn_exp2f(mrun - mn); mrun = mn;
        float ls = 0.f;
#pragma unroll
        for (int r = 0; r < 16; ++r) { p0[r] = __builtin_amdgcn_exp2f(p0[r] - mn); p1[r] = __builtin_amdgcn_exp2f(p1[r] - mn); ls += p0[r] + p1[r]; }
        lrun = lrun * f + ls;
        if (hi == 0) wsf[r32] = f;
        asm volatile("s_waitcnt lgkmcnt(0)" ::: "memory");
        float fr[16];
#pragma unroll
        for (int r = 0; r < 16; ++r) fr[r] = wsf[crow(r, hi)];
        asm volatile("s_waitcnt lgkmcnt(0)" ::: "memory");
#pragma unroll
        for (int db = 0; db < 4; ++db)
#pragma unroll
            for (int r = 0; r < 16; ++r) o[db][r] *= fr[r];
        bf16x8 pa[4];
        { v4u w;
          w.x = gm::cvt_pk_bf16(p0[0], p0[1]); w.y = gm::cvt_pk_bf16(p0[2], p0[3]); w.z = gm::cvt_pk_bf16(p0[4], p0[5]); w.w = gm::cvt_pk_bf16(p0[6], p0[7]); pa[0] = __builtin_bit_cast(bf16x8, w);
          w.x = gm::cvt_pk_bf16(p0[8], p0[9]); w.y = gm::cvt_pk_bf16(p0[10], p0[11]); w.z = gm::cvt_pk_bf16(p0[12], p0[13]); w.w = gm::cvt_pk_bf16(p0[14], p0[15]); pa[1] = __builtin_bit_cast(bf16x8, w);
          w.x = gm::cvt_pk_bf16(p1[0], p1[1]); w.y = gm::cvt_pk_bf16(p1[2], p1[3]); w.z = gm::cvt_pk_bf16(p1[4], p1[5]); w.w = gm::cvt_pk_bf16(p1[6], p1[7]); pa[2] = __builtin_bit_cast(bf16x8, w);
          w.x = gm::cvt_pk_bf16(p1[8], p1[9]); w.y = gm::cvt_pk_bf16(p1[10], p1[11]); w.z = gm::cvt_pk_bf16(p1[12], p1[13]); w.w = gm::cvt_pk_bf16(p1[14], p1[15]); pa[3] = __builtin_bit_cast(bf16x8, w); }
#pragma unroll
        for (int db = 0; db < 4; ++db) { const LAS unsigned char* vb = lds + L_V + (32 * db + r32) * VROW + (64 * jt + 8 * hi) * 2;
#pragma unroll
            for (int ks = 0; ks < 4; ++ks) { const bf16x8 vf = *(const LAS bf16x8*)(vb + 32 * ks); o[db] = __builtin_amdgcn_mfma_f32_32x32x16_bf16(pa[ks], vf, o[db], 0, 0, 0); } }
    }
    { const auto rr = __builtin_amdgcn_permlane32_swap(__float_as_uint(lrun), __float_as_uint(lrun), false, false); lrun = __uint_as_float(rr[0]) + __uint_as_float(rr[1]); }
    if (hi == 0) wsf[32 + r32] = __builtin_amdgcn_rcpf(lrun);
    asm volatile("s_waitcnt lgkmcnt(0)" ::: "memory");
    bf16* ob = MO + (size_t)(rowblk * 256 + 32 * wid) * 512 + h * 128 + r32;
#pragma unroll
    for (int r = 0; r < 16; ++r) { const int qrow = crow(r, hi); const float rl = wsf[32 + qrow];
#pragma unroll
        for (int db = 0; db < 4; ++db) ob[(size_t)qrow * 512 + 32 * db] = (bf16)f2bf(o[db][r] * rl); }
    asm volatile("s_waitcnt lgkmcnt(0)" ::: "memory");
    __syncthreads();
}
}

struct Args { const float* in[19]; float* out; unsigned char* ws; };
struct Ctx { LAS unsigned char* lds; volatile LAS unsigned* MISC; GAS unsigned* ctl; int tid, lane, wave, vcu, G; };

__device__ __forceinline__ void transpose_item(const float* W, int ldw, int mode, int c0, bf16* WT, int ldt, int kcol0, int k0, int n0, LAS float* scr, int lane) {
    const int j = lane & 31, sc = (mode == 1) ? in_src_col(n0 + j) : c0 + j;
    const GAS float* wp_ = (const GAS float*)W + (size_t)(k0 + (lane >> 5)) * ldw + (sc >= 0 ? sc : 0);
#pragma unroll 1
    for (int h = 0; h < 2; ++h) { float t_[16];
#pragma unroll
        for (int i = 0; i < 16; ++i) t_[i] = wp_[(size_t)(2 * (16 * h + i)) * ldw];
#pragma unroll
        for (int i = 0; i < 16; ++i) scr[(2 * (16 * h + i) + (lane >> 5)) * 33 + j] = (sc >= 0) ? t_[i] : 0.f; }
    LDS_WAIT(); asm volatile("" ::: "memory");
    const int c = lane & 7;
#pragma unroll
    for (int jj = 0; jj < 4; ++jj) { const int n = (lane >> 3) + 8 * jj; const LAS float* s = scr + (8 * c) * 33 + n;
        v4u o; o.x = pk2(s[0 * 33], s[1 * 33]); o.y = pk2(s[2 * 33], s[3 * 33]); o.z = pk2(s[4 * 33], s[5 * 33]); o.w = pk2(s[6 * 33], s[7 * 33]);
        *(GAS v4u*)(WT + (size_t)(n0 + n) * ldt + kcol0 + k0 + 8 * c) = o; }
    LDS_WAIT(); asm volatile("" ::: "memory");
}
__device__ __forceinline__ void sincos_d(double a, float& sn, float& cs) {
    const double q = rint(a * 0.63661977236758134308); const double r = fma(-q, 1.57079632679489655800, a) - q * 6.12323399573676603587e-17; const int qi = ((int)q) & 3;
    const double r2 = r * r;
    const double s = r * (1.0 + r2 * (-1.0 / 6 + r2 * (1.0 / 120 + r2 * (-1.0 / 5040 + r2 * (1.0 / 362880 + r2 * (-1.0 / 39916800 + r2 * (1.0 / 6227020800.0)))))));
    const double c = 1.0 + r2 * (-0.5 + r2 * (1.0 / 24 + r2 * (-1.0 / 720 + r2 * (1.0 / 40320 + r2 * (-1.0 / 3628800 + r2 * (1.0 / 479001600.0 + r2 * (-1.0 / 87178291200.0)))))));
    const double ss = (qi == 0) ? s : ((qi == 1) ? c : ((qi == 2) ? -s : -c)), cc = (qi == 0) ? c : ((qi == 1) ? -s : ((qi == 2) ? -c : s));
    sn = (float)ss; cs = (float)cc;
}
__device__ __forceinline__ void p0_prologue(const Args& a, const Ctx& F) {
    unsigned char* ws = a.ws;
    const int gw = F.vcu * NWAVES + F.wave, NGW = F.G * NWAVES, lane = F.lane;
    LAS float* scr = (LAS float*)(F.lds + F.wave * 16384);
#ifndef P0SUB
#define P0SUB 0
#endif
    { const size_t gt0 = (size_t)F.vcu * (NWAVES * 64) + F.tid;
      if (gt0 < 256 * D / 8) { const f32x4 v0 = ((const GAS f32x4*)a.in[1])[2 * gt0], v1 = ((const GAS f32x4*)a.in[1])[2 * gt0 + 1];
          v4u o; o.x = pk2(v0.x, v0.y); o.y = pk2(v0.z, v0.w); o.z = pk2(v1.x, v1.y); o.w = pk2(v1.z, v1.w); ((GAS v4u*)(ws + WS_MEMB))[gt0] = o; } }
    for (int it = gw; it < NL * 4 * 16 * 16; it += NGW) { const int l = it >> 10, g = (it >> 8) & 3, db = (it >> 4) & 15, cb = it & 15, d = db * 64 + lane;
        const float* pw = a.in[5] + ((size_t)(l * 4 + g) * 128 + cb * 8) * 128; const float* ps = a.in[6] + (size_t)l * 512 + g * 128; const float* wb = a.in[8] + (size_t)l * 3 * 512 * D + (size_t)g * 128 * D + d;
        float acc[8];
#pragma unroll
        for (int i = 0; i < 8; ++i) acc[i] = 0.f;
#pragma unroll 1
        for (int e0 = 0; e0 < 128; e0 += 16) { float w[16];
#pragma unroll
            for (int ee = 0; ee < 16; ++ee) w[ee] = ((const GAS float*)wb)[(size_t)(e0 + ee) * D];
#pragma unroll
            for (int ee = 0; ee < 16; ++ee) { const float ws_ = w[ee] * ps[e0 + ee];
#pragma unroll
                for (int i = 0; i < 8; ++i) acc[i] = fmaf(pw[(size_t)i * 128 + e0 + ee], ws_, acc[i]); } }
        v4u o; o.x = pk2(acc[0], acc[1]); o.y = pk2(acc[2], acc[3]); o.z = pk2(acc[4], acc[5]); o.w = pk2(acc[6], acc[7]);
        *(GAS v4u*)((bf16*)(ws + WS_WBR + (size_t)l * WBR_BYTES) + (size_t)d * 1536 + g * 128 + cb * 8) = o;
    }
    { constexpr int I_IN = 16 * (N1 / 32), I_BR = 8 * 32, I_OUT = 16 * 32, I_MEM = 16 * 32, PER_L = I_IN + 2 * I_BR + I_OUT + I_MEM;
      for (int repc_ = 0; repc_ < ((P0SUB == 2) ? 2 : 1); ++repc_)
      for (int it = gw; it < NL * PER_L; it += NGW) { const int l = it / PER_L; int r = it % PER_L;
          if (r < I_IN) { const int kb = r / (N1 / 32), nb = r % (N1 / 32); transpose_item(a.in[3] + (size_t)l * D * DIN, DIN, 1, 0, (bf16*)(ws + WS_WIN + (size_t)l * WIN_BYTES), D, 0, 64 * kb, 32 * nb, scr, lane); continue; } r -= I_IN;
          if (r < 2 * I_BR) { const int n = 1 + r / I_BR, rr = r % I_BR, kb = rr / 32, nb = rr % 32;
              transpose_item(a.in[8] + ((size_t)l * 3 + n) * 512 * D, D, 0, 32 * nb, (bf16*)(ws + WS_WBR + (size_t)l * WBR_BYTES), 1536, 512 * n, 64 * kb, 32 * nb, scr, lane); continue; } r -= 2 * I_BR;
          if (r < I_OUT) { const int kb = r / 32, nb = r % 32; transpose_item(a.in[9] + (size_t)l * D * D, D, 0, 32 * nb, (bf16*)(ws + WS_WOUT + (size_t)l * WOUT_BYTES), D, 0, 64 * kb, 32 * nb, scr, lane); continue; } r -= I_OUT;
          { const int kb = r / 32, nb = r % 32; transpose_item(a.in[7] + (size_t)l * D * 1024, 1024, 0, 32 * nb, (bf16*)(ws + WS_WMEM) + (size_t)l * 1024 * D, D, 0, 64 * kb, 32 * nb, scr, lane); } } }
    const size_t gt = (size_t)F.vcu * (NWAVES * 64) + F.tid, NGT = (size_t)F.G * NWAVES * 64;
    for (size_t i = gt; i < (size_t)NL * N1; i += NGT) { const int l = (int)(i / N1), j = (int)(i % N1), sc = in_src_col(j); ((float*)(ws + WS_BIAS))[i] = (sc >= 0) ? a.in[4][(size_t)l * DIN + sc] : 0.f; }
    const float invf = powf(10000.0f, -(float)(int)(gt & 31) * (1.0f / 32.0f));
    static_assert((NWAVES * 64) % 32 == 0, "rotary table: one frequency per thread");
    for (int repr_ = 0; repr_ < ((P0SUB == 4) ? 2 : 1); ++repr_)
    for (size_t i = gt; i < (size_t)S * 32; i += NGT) { const int t = (int)(i >> 5);
        const float ang = (float)((const int*)a.in[2])[t] * invf;
        float sn, cs; sincos_d((double)ang, sn, cs); ((float*)(ws + WS_RCOS))[i] = cs; ((float*)(ws + WS_RSIN))[i] = sn; }
    for (int repd_ = 0; repd_ < ((P0SUB == 3) ? 2 : 1); ++repd_)
#pragma unroll 2
    for (size_t i = gt; i < (size_t)S * D / 8; i += NGT) { const f32x4 v0 = ((const GAS f32x4*)a.in[0])[2 * i], v1 = ((const GAS f32x4*)a.in[0])[2 * i + 1];
        v4u o; o.x = pk2(v0.x, v0.y); o.y = pk2(v0.z, v0.w); o.z = pk2(v1.x, v1.y); o.w = pk2(v1.z, v1.w); ((GAS v4u*)(ws + WS_XB))[i] = o; }
}
__device__ __forceinline__ void pool_diff(const bf16* PU, bf16* PD, const Ctx& F) {
    const size_t gt = (size_t)F.vcu * (NWAVES * 64) + F.tid, NGT = (size_t)F.G * NWAVES * 64;
    for (size_t i = gt; i < (size_t)S * 64; i += NGT) { const int t = (int)(i >> 6), ch = (int)(i & 63), w = 2 << (ch >> 4), cntw = (t + 1 < w) ? t + 1 : w;
        const GAS v4u* p = (const GAS v4u*)(PU + (size_t)t * 512 + ch * 8);
        const v4u u0 = p[0]; float s[8] = {gm::bf_lo(u0.x), gm::bf_hi(u0.x), gm::bf_lo(u0.y), gm::bf_hi(u0.y), gm::bf_lo(u0.z), gm::bf_hi(u0.z), gm::bf_lo(u0.w), gm::bf_hi(u0.w)};
        float self[8];
#pragma unroll
        for (int k = 0; k < 8; ++k) self[k] = s[k];
        v4u vv[15];
#pragma unroll
        for (int j = 1; j < 16; ++j) vv[j - 1] = (j < cntw) ? *(p - (size_t)j * 64) : (v4u){0u, 0u, 0u, 0u};
#pragma unroll
        for (int j = 1; j < 16; ++j) { const v4u v = vv[j - 1];
            s[0] += gm::bf_lo(v.x); s[1] += gm::bf_hi(v.x); s[2] += gm::bf_lo(v.y); s[3] += gm::bf_hi(v.y); s[4] += gm::bf_lo(v.z); s[5] += gm::bf_hi(v.z); s[6] += gm::bf_lo(v.w); s[7] += gm::bf_hi(v.w); }
        const float inv = 1.0f / (float)cntw;
        v4u o; o.x = pk2(s[0] * inv - self[0], s[1] * inv - self[1]); o.y = pk2(s[2] * inv - self[2], s[3] * inv - self[3]); o.z = pk2(s[4] * inv - self[4], s[5] * inv - self[5]); o.w = pk2(s[6] * inv - self[6], s[7] * inv - self[7]);
        *(GAS v4u*)(PD + (size_t)t * 512 + ch * 8) = o; }
}
__device__ __forceinline__ void ln1_route(const float* X, float* XO, bool lists, bf16* XB, const float* g1, const float* b1, const float* wrt, const float* rbias, unsigned* toks, float* gl, GAS unsigned* ecnt, const Ctx& F) {
    LAS float* wl = (LAS float*)F.lds;
    LAS int* sel = (LAS int*)(F.lds + 65536);
    LAS float* selw = (LAS float*)(F.lds + 65536 + 1024);
    LAS unsigned* lcnt = (LAS unsigned*)(F.lds + 65536 + 2048);
    { f32x4 wq[8];
#pragma unroll
      for (int k = 0; k < 8; ++k) wq[k] = ((const GAS f32x4*)wrt)[F.tid + 512 * k];
#pragma unroll
      for (int k = 0; k < 8; ++k) { const int i4 = F.tid + 512 * k, c = i4 >> 2, e0 = (i4 & 3) * 4; wl[(e0 + 0) * D + c] = wq[k].x; wl[(e0 + 1) * D + c] = wq[k].y; wl[(e0 + 2) * D + c] = wq[k].z; wl[(e0 + 3) * D + c] = wq[k].w; } }
    if (F.tid < 32) lcnt[F.tid] = 0u;
    __syncthreads();
    const int lane = F.lane;
    for (int rb = F.vcu; rb < S / 64; rb += F.G) {
        f32x4 vn[4];
        { const GAS f32x4* x0 = (const GAS f32x4*)(X + (size_t)(rb * 64 + F.wave * 8) * D) + lane;
#pragma unroll
          for (int j = 0; j < 4; ++j) vn[j] = x0[64 * j]; }
#pragma unroll 1
        for (int rr = 0; rr < 8; ++rr) { const int rl = F.wave * 8 + rr, row = rb * 64 + rl;
            GAS f32x4* xo = (GAS f32x4*)(XO + (size_t)row * D) + lane;
            f32x4 v[4]; float s = 0.f;
#pragma unroll
            for (int j = 0; j < 4; ++j) { v[j] = vn[j]; s += (v[j].x + v[j].y) + (v[j].z + v[j].w); }
            { const GAS f32x4* x1 = (const GAS f32x4*)(X + (size_t)(row + (rr < 7 ? 1 : 0)) * D) + lane;
#pragma unroll
              for (int j = 0; j < 4; ++j) vn[j] = x1[64 * j]; }
            const float mean = wave_sum(s) * (1.f / D); float s2 = 0.f;
#pragma unroll
            for (int j = 0; j < 4; ++j) { v[j] = v[j] - mean; s2 += (v[j].x * v[j].x + v[j].y * v[j].y) + (v[j].z * v[j].z + v[j].w * v[j].w); }
            const float rstd = 1.f / sqrtf(wave_sum(s2) * (1.f / D) + LN_EPS);
            GAS unsigned long long* o8 = (GAS unsigned long long*)(XB + (size_t)row * D) + lane;
#pragma unroll
            for (int j = 0; j < 4; ++j) { const f32x4 gg = ((const GAS f32x4*)g1)[64 * j + lane], bb = ((const GAS f32x4*)b1)[64 * j + lane]; v[j] = v[j] * rstd * gg + bb; xo[64 * j] = v[j];
                o8[64 * j] = (unsigned long long)pk2(v[j].x, v[j].y) | ((unsigned long long)pk2(v[j].z, v[j].w) << 32); }
            float pl[NEXP];
#pragma unroll
            for (int e = 0; e < NEXP; ++e) { float p = 0.f;
#pragma unroll
                for (int j = 0; j < 4; ++j) { const f32x4 w = *(const LAS f32x4*)(wl + e * D + 256 * j + 4 * lane); p += (v[j].x * w.x + v[j].y * w.y) + (v[j].z * w.z + v[j].w * w.w); }
                pl[e] = p; }
            float r8[8], r4[4], r2[2], r1;
#pragma unroll
            for (int i = 0; i < 8; ++i) { const bool up = (lane & 32) != 0; const float mine = up ? pl[8 + i] : pl[i], send = up ? pl[i] : pl[8 + i]; r8[i] = mine + __shfl_xor(send, 32); }
#pragma unroll
            for (int i = 0; i < 4; ++i) { const bool up = (lane & 16) != 0; const float mine = up ? r8[4 + i] : r8[i], send = up ? r8[i] : r8[4 + i]; r4[i] = mine + __shfl_xor(send, 16); }
#pragma unroll
            for (int i = 0; i < 2; ++i) { const bool up = (lane & 8) != 0; const float mine = up ? r4[2 + i] : r4[i], send = up ? r4[i] : r4[2 + i]; r2[i] = mine + __shfl_xor(send, 8); }
            { const bool up = (lane & 4) != 0; const float mine = up ? r2[1] : r2[0], send = up ? r2[0] : r2[1]; r1 = mine + __shfl_xor(send, 4); }
            r1 += __shfl_xor(r1, 2); r1 += __shfl_xor(r1, 1);
            const float sg1 = 1.0f / (1.0f + expf(-r1));
            float sc[NEXP], bs[NEXP];
#pragma unroll
            for (int e = 0; e < NEXP; ++e) { sc[e] = __builtin_bit_cast(float, __builtin_amdgcn_readlane(__builtin_bit_cast(int, sg1), ((e >> 3) & 1) * 32 + ((e >> 2) & 1) * 16 + ((e >> 1) & 1) * 8 + (e & 1) * 4)); bs[e] = sc[e] + rbias[e]; }
            float gs[4];
#pragma unroll
            for (int g = 0; g < 4; ++g) { const float a_ = fmaxf(bs[4 * g], bs[4 * g + 1]), b_ = fminf(bs[4 * g], bs[4 * g + 1]), c_ = fmaxf(bs[4 * g + 2], bs[4 * g + 3]), d_ = fminf(bs[4 * g + 2], bs[4 * g + 3]);
                gs[g] = fmaxf(a_, c_) + fmaxf(fminf(a_, c_), fmaxf(b_, d_)); }
            int best = 0; float bg = gs[0];
#pragma unroll
            for (int g = 1; g < 4; ++g) if (gs[g] > bg) { bg = gs[g]; best = g; }
            float wb[4], ws_[4];
#pragma unroll
            for (int i = 0; i < 4; ++i) { wb[i] = (best == 0) ? bs[i] : ((best == 1) ? bs[4 + i] : ((best == 2) ? bs[8 + i] : bs[12 + i])); ws_[i] = (best == 0) ? sc[i] : ((best == 1) ? sc[4 + i] : ((best == 2) ? sc[8 + i] : sc[12 + i])); }
            int i1 = 0; float m1 = wb[0];
#pragma unroll
            for (int i = 1; i < 4; ++i) if (wb[i] > m1) { m1 = wb[i]; i1 = i; }
            int i2 = -1; float m2 = 0.f;
#pragma unroll
            for (int i = 0; i < 4; ++i) if (i != i1 && (i2 < 0 || wb[i] > m2)) { m2 = wb[i]; i2 = i; }
            const float w1 = (i1 == 0) ? ws_[0] : ((i1 == 1) ? ws_[1] : ((i1 == 2) ? ws_[2] : ws_[3])), w2 = (i2 == 0) ? ws_[0] : ((i2 == 1) ? ws_[1] : ((i2 == 2) ? ws_[2] : ws_[3]));
            const float wsum = w1 + w2;
            if (lane == 0) { const int e0 = 4 * best + i1, e1 = 4 * best + i2;
                sel[rl * 4 + 0] = e0; sel[rl * 4 + 1] = e1;
                sel[rl * 4 + 2] = (int)__hip_atomic_fetch_add(lcnt + e0, 1u, __ATOMIC_RELAXED, __HIP_MEMORY_SCOPE_WORKGROUP);
                sel[rl * 4 + 3] = (int)__hip_atomic_fetch_add(lcnt + e1, 1u, __ATOMIC_RELAXED, __HIP_MEMORY_SCOPE_WORKGROUP);
                selw[rl * 2 + 0] = w1 / wsum; selw[rl * 2 + 1] = w2 / wsum; }
        }
        LDS_WAIT(); __syncthreads();
        if (F.tid < NEXP && lists) lcnt[16 + F.tid] = __hip_atomic_fetch_add(ecnt + 64 * F.tid, lcnt[F.tid], __ATOMIC_RELAXED, __HIP_MEMORY_SCOPE_AGENT);
        LDS_WAIT(); __syncthreads();
        if (F.tid < 128 && lists) { const int rl = F.tid >> 1, k = F.tid & 1, e = sel[rl * 4 + k]; const unsigned pos = lcnt[16 + e] + (unsigned)sel[rl * 4 + 2 + k];
            toks[(size_t)e * CAPE + pos] = (unsigned)((rb * 64 + rl) * 2 + k); gl[(size_t)e * CAPE + pos] = selw[rl * 2 + k]; }
        LDS_WAIT(); __syncthreads();
        if (F.tid < 32) lcnt[F.tid] = 0u;
        LDS_WAIT(); __syncthreads();
    }
}
__device__ __forceinline__ void moe_weights(const float* w1, const float* w3, const float* w2, bf16* W13, bf16* W2T, const Ctx& F) {
    const int gw = F.vcu * NWAVES + F.wave, NGW = F.G * NWAVES; LAS float* scr = (LAS float*)(F.lds + 69632 + F.wave * 8704);
    constexpr int I13 = 16 * 32, I2 = 8 * 32;
    for (int it = gw; it < NEXP * (I13 + I2); it += NGW) { const int e = it / (I13 + I2); int r = it % (I13 + I2);
        if (r < I13) { const int kb = r >> 5, nb = r & 31, n0 = 32 * nb, rr = n0 & 255, pn = n0 >> 8; const float* W = ((rr < 128) ? w1 : w3) + (size_t)e * D * DEXP;
            transpose_item(W, DEXP, 0, pn * 128 + (rr & 127), W13 + (size_t)e * 1024 * 1024, 1024, 0, 64 * kb, n0, scr, F.lane); }
        else { r -= I13; const int kb = r >> 5, nb = r & 31; transpose_item(w2 + (size_t)e * DEXP * D, D, 0, 32 * nb, W2T + (size_t)e * 1024 * 512, 512, 0, 64 * kb, 32 * nb, scr, F.lane); } }
}
__device__ __forceinline__ void ln2_rows(const float* X, float* XO, const bf16* O2, bf16* XB, const float* g2, const float* b2, const Ctx& F) {
    const int gw = F.vcu * NWAVES + F.wave, NGW = F.G * NWAVES, lane = F.lane;
    f32x4 xn[4]; unsigned long long an[4], bn[4];
    if (gw < S) { const GAS f32x4* x0 = (const GAS f32x4*)(X + (size_t)gw * D) + lane; const GAS unsigned long long* o0 = (const GAS unsigned long long*)(O2 + (size_t)gw * 2 * D) + lane;
#pragma unroll
        for (int j = 0; j < 4; ++j) { xn[j] = x0[64 * j]; an[j] = o0[64 * j]; bn[j] = o0[256 + 64 * j]; } }
#pragma unroll 1
    for (int row = gw; row < S; row += NGW) {
        GAS f32x4* xo = (GAS f32x4*)(XO + (size_t)row * D) + lane;
        f32x4 xr[4]; unsigned long long oa[4], ob[4];
#pragma unroll
        for (int j = 0; j < 4; ++j) { xr[j] = xn[j]; oa[j] = an[j]; ob[j] = bn[j]; }
        { const int rn = (row + NGW < S) ? row + NGW : row; const GAS f32x4* x1 = (const GAS f32x4*)(X + (size_t)rn * D) + lane; const GAS unsigned long long* o1 = (const GAS unsigned long long*)(O2 + (size_t)rn * 2 * D) + lane;
#pragma unroll
          for (int j = 0; j < 4; ++j) { xn[j] = x1[64 * j]; an[j] = o1[64 * j]; bn[j] = o1[256 + 64 * j]; } }
        f32x4 v[4]; float s = 0.f;
#pragma unroll
        for (int j = 0; j < 4; ++j) { const unsigned long long a = oa[j], b = ob[j]; const unsigned a0 = (unsigned)a, a1 = (unsigned)(a >> 32), b0 = (unsigned)b, b1 = (unsigned)(b >> 32);
            v[j] = xr[j] * DN_ALPHA + ((f32x4){gm::bf_lo(a0), gm::bf_hi(a0), gm::bf_lo(a1), gm::bf_hi(a1)} + (f32x4){gm::bf_lo(b0), gm::bf_hi(b0), gm::bf_lo(b1), gm::bf_hi(b1)});
            s += (v[j].x + v[j].y) + (v[j].z + v[j].w); }
        const float mean = wave_sum(s) * (1.f / D); float s2 = 0.f;
#pragma unroll
        for (int j = 0; j < 4; ++j) { v[j] = v[j] - mean; s2 += (v[j].x * v[j].x + v[j].y * v[j].y) + (v[j].z * v[j].z + v[j].w * v[j].w); }
        const float rstd = 1.f / sqrtf(wave_sum(s2) * (1.f / D) + LN_EPS);
        GAS unsigned long long* o8 = (GAS unsigned long long*)(XB + (size_t)row * D) + lane;
#pragma unroll
        for (int j = 0; j < 4; ++j) { const f32x4 gg = ((const GAS f32x4*)g2)[64 * j + lane], bb = ((const GAS f32x4*)b2)[64 * j + lane]; v[j] = v[j] * rstd * gg + bb; xo[64 * j] = v[j];
            o8[64 * j] = (unsigned long long)pk2(v[j].x, v[j].y) | ((unsigned long long)pk2(v[j].z, v[j].w) << 32); }
    }
}

__global__ void __launch_bounds__(NWAVES * 64, 2) hybrid_fwd(Args args) {
    extern __shared__ __attribute__((aligned(16))) unsigned char lds[];
    Ctx F;
    F.lds = (LAS unsigned char*)lds; F.MISC = (volatile LAS unsigned*)(F.lds + LDSCTL_OFF);
    F.tid = threadIdx.x; F.lane = F.tid & 63; F.wave = __builtin_amdgcn_readfirstlane(F.tid >> 6);
    const int wave_s = F.wave;
    F.G = gridDim.x; { const int bx = blockIdx.x; F.vcu = (F.G % 8 == 0) ? (bx % 8) * (F.G / 8) + bx / 8 : bx; }
    const int vcu0 = F.vcu;
    unsigned char* ws = args.ws; F.ctl = (GAS unsigned*)(ws + WS_CTL);
    if (F.tid < 64) ((LAS unsigned*)(F.lds + LDSCTL_OFF))[F.tid] = 0u;
    __syncthreads();
    (void)xcd_barrier_post((unsigned*)(F.ctl + CW_BAR), F.MISC + 8);

#define GRID_BAR() do { XcdBarrier b_; unsigned char* w_ = args.ws; asm volatile("" : "+s"(w_)); b_.bar = (unsigned*)(w_ + WS_CTL) + CW_BAR; b_.x = xb_xcc_id(); b_.st = (volatile LAS unsigned*)(F.lds + LDSCTL_OFF) + 8; b_.w = wave_s; xcd_barrier(b_); RELAUNDER(); } while (0)
#define RELAUNDER() do { int t_ = (wave_s << 6) | gm::gm_lane_id(); asm volatile("" : "+v"(t_)); F.tid = t_; F.lane = t_ & 63; F.wave = wave_s; unsigned z_ = 0u; int v_ = vcu0, g_ = (int)gridDim.x; asm volatile("" : "+s"(z_), "+s"(v_), "+s"(g_)); F.lds = (LAS unsigned char*)lds + z_; F.vcu = v_; F.G = g_; } while (0)
#ifndef PHM
#define PHM 0xFFFF
#endif
#define PHMARK(k) asm volatile("; PHASE_MARK " #k ::: "memory")
#ifndef DUPM
#define DUPM 0
#endif
#define NREP(k) ((((DUPM) >> (k)) & 1) ? 2 : 1)
#define PH(k) PHMARK(k); if constexpr ((PHM >> (k)) & 1) _Pragma("unroll 1") for (int rep_ = 0; rep_ < NREP(k); ++rep_)
#ifndef NPASS
#define NPASS 1
#endif
  _Pragma("unroll 1") for (int pass_ = 0; pass_ < NPASS; ++pass_) {
    PH(0) p0_prologue(args, F);
    GRID_BAR();

#pragma unroll 1
    for (int l = 0; l < NL; ++l) {
        RELAUNDER();
        const __attribute__((address_space(4))) Args* ka = (const __attribute__((address_space(4))) Args*)__builtin_amdgcn_kernarg_segment_ptr(); asm volatile("" : "+s"(ka));
#define AIN(k) (ka->in[k])
        unsigned char* ws = ka->ws; float* out = ka->out; asm volatile("" : "+s"(ws), "+s"(out));
        bf16* const XB = (bf16*)(ws + WS_XB);
        const size_t mask_off = (l == 0) ? WS_MASK : WS_XB;
        PH(1) {   gm::ProbDense<1> P{(const char*)XB, nullptr, nullptr, (const char*)(ws + WS_WIN + (size_t)l * WIN_BYTES), S, N1, D, D, F.G, (int)blockIdx.x, WGM_P1};
            gm::EpiProj E{ws, (const float*)(ws + WS_BIAS) + (size_t)l * N1};
            gm::gemm_phase(F.lds, P, E, F.wave); }
        if (l == 0 && blockIdx.x >= 64 && blockIdx.x < 72) { RELAUNDER();
            gm::ProbDense<1> PM{(const char*)(ws + WS_MEMB), nullptr, nullptr, (const char*)(ws + WS_WMEM), 256, 2048, D, D, 8, (int)blockIdx.x - 64, 1};
            gm::EpiMemKV EM{(bf16*)(ws + WS_MEMK), (bf16*)(ws + WS_MEMV)};
            gm::gemm_phase(F.lds, PM, EM, F.wave); }
        GRID_BAR();
#ifndef XBAR
#define XBAR 0
#endif
        for (int xb_ = 0; xb_ < XBAR; ++xb_) GRID_BAR();
        PH(2) pool_diff((const bf16*)(ws + WS_PU), (bf16*)(ws + WS_PD), F);
        RELAUNDER();
        PH(3) for (int u = F.vcu; u < 256; u += F.G) { const int h = u & 3;
            ma::mem_unit(u >> 2, h, (const bf16*)(ws + WS_MEMK) + (size_t)(l * 4 + h) * 256 * 128, (const bf16*)(ws + WS_MEMV) + (size_t)(l * 4 + h) * 128 * 256, (bf16*)(ws + WS_MQ), (bf16*)(ws + ((NREP(3) == 2 && rep_ == 0) ? ((l == 0) ? WS_XB : WS_MASK) : WS_MQ)), F.lds, F.tid, F.lane, F.wave); }
        RELAUNDER();
        PH(4) for (int p = F.vcu; p < 256; p += F.G) {
            ix::indexer_unit(511 - p, (const bf16*)(ws + WS_IQ), (const bf16*)(ws + WS_IK), (const float*)(ws + WS_IW), (unsigned long long*)(ws + mask_off), F.lds, F.tid, F.lane, F.wave, IXDRY != 0 && NREP(4) == 2 && rep_ == 0);
            ix::indexer_unit(p, (const bf16*)(ws + WS_IQ), (const bf16*)(ws + WS_IK), (const float*)(ws + WS_IW), (unsigned long long*)(ws + mask_off), F.lds, F.tid, F.lane, F.wave, IXDRY != 0 && NREP(4) == 2 && rep_ == 0); }
        GRID_BAR();
        PH(5) {
            const attn_body::AttnTensors AT{(const attn_body::bf16*)(ws + WS_Q), (const attn_body::bf16*)(ws + WS_K), (const attn_body::bf16*)(ws + WS_V), (attn_body::bf16*)(ws + ((NREP(5) == 2 && rep_ == 0) ? WS_PU : WS_Q)), (const unsigned long long*)(ws + mask_off), F.wave};
            const attn_body::StaticOrder SO((int)F.G, (int)blockIdx.x);
            attn_body::attn_phase<attn_body::StaticOrder>((char*)lds, AT, SO); }
        GRID_BAR();
        PH(6) {   gm::ProbDense<3> P{(const char*)(ws + WS_PD), (const char*)(ws + WS_Q), (const char*)(ws + WS_MQ), (const char*)(ws + WS_WBR + (size_t)l * WBR_BYTES), S, D, 1536, 512, F.G, (int)blockIdx.x, WGM_P4};
            gm::EpiMerge E{(const bf16*)(ws + WS_GATE), XB};
            gm::gemm_phase(F.lds, P, E, F.wave); }
        GRID_BAR();
        PHMARK(7); _Pragma("unroll 1") for (int rep_ = 0; rep_ < ((l == 0) ? NREP(7) : 1); ++rep_) {   gm::ProbDense<1> P{(const char*)XB, nullptr, nullptr, (const char*)(ws + WS_WOUT + (size_t)l * WOUT_BYTES), S, D, D, D, F.G, (int)blockIdx.x, WGM_P5};
            gm::EpiRes E{(l == 0) ? AIN(0) : (const float*)out, out};
            gm::gemm_phase(F.lds, P, E, F.wave); }
        GRID_BAR();
        GAS unsigned* ecnt = F.ctl + CW_ECNT + (pass_ * NL + l) * 16 * 64;
        unsigned* toks = (unsigned*)(ws + WS_TOK) + (size_t)l * NEXP * CAPE; float* gl = (float*)(ws + WS_GL) + (size_t)l * NEXP * CAPE;
        PH(8) ln1_route(out, (NREP(8) == 2 && rep_ == 0) ? (float*)(ws + WS_O2) : out, !(NREP(8) == 2 && rep_ == 0), XB, AIN(10) + (size_t)l * D, AIN(11) + (size_t)l * D, AIN(12), AIN(13), toks, gl, ecnt, F);
        RELAUNDER();
        PH(9) moe_weights(AIN(14) + (size_t)l * NEXP * D * DEXP, AIN(15) + (size_t)l * NEXP * D * DEXP, AIN(16) + (size_t)l * NEXP * DEXP * D, (bf16*)(ws + WS_W13), (bf16*)(ws + WS_W2T), F);
        GRID_BAR();
        {   LAS int* tl = (LAS int*)(F.lds + LDSCTL_OFF + 64);
            if (F.tid < 64) { const int e = F.tid & 15; const int c = (int)__hip_atomic_load(ecnt + 64 * e, __ATOMIC_RELAXED, __HIP_MEMORY_SCOPE_AGENT); const int nb = (c + 255) >> 8; int x = nb;
#pragma unroll
                for (int o = 1; o < 16; o <<= 1) { const int y = __shfl_up(x, o); if ((F.tid & 15) >= o) x += y; }
                if (F.tid < 16) { tl[e] = x - nb; tl[17 + e] = c; if (e == 15) tl[16] = x; } }
            LDS_WAIT(); __syncthreads();
            PH(10) { gm::ProbMoe<true> P1{(const char*)XB, (const char*)(ws + WS_W13), (const int*)toks, D, D, F.G, F.vcu, tl};
            gm::EpiSwiglu E1{(bf16*)(ws + WS_H)};
            gm::gemm_phase(F.lds, P1, E1, F.wave); }
            GRID_BAR();
            PH(11) { gm::ProbMoe<false> P2{(const char*)(ws + WS_H), (const char*)(ws + WS_W2T), (const int*)toks, DEXP, DEXP, F.G, F.vcu, tl};
            gm::EpiMoeOut E2{toks, gl, tl + 17, (bf16*)(ws + WS_O2)};
            gm::gemm_phase(F.lds, P2, E2, F.wave); }
        }
        GRID_BAR();
        PH(12) ln2_rows(out, (NREP(12) == 2 && rep_ == 0) ? (float*)(ws + WS_W13) : out, (const bf16*)(ws + WS_O2), XB, AIN(17) + (size_t)l * D, AIN(18) + (size_t)l * D, F);
        if (l + 1 < NL || pass_ + 1 < NPASS) GRID_BAR();
    }
  }
}

extern "C" void kernel_launch(void* const* d_in, const int* in_sizes, int n_in, void* d_out, int out_size, void* d_ws, size_t ws_size, hipStream_t stream) {
    static int grid = 0;
    if (grid == 0) {
        if (n_in != 19 || in_sizes[0] != S * D || out_size != S * D || ws_size < WS_END) { fprintf(stderr, "kernel_launch: unexpected problem (n_in %d, in0 %d, out %d, ws %zu < %zu); nothing launched\n", n_in, n_in > 0 ? in_sizes[0] : -1, out_size, ws_size, (size_t)WS_END); grid = -1; return; }
        int dev = 0, cus = 0, per_cu = 0;
        if (hipGetDevice(&dev) != hipSuccess || hipDeviceGetAttribute(&cus, hipDeviceAttributeMultiprocessorCount, dev) != hipSuccess) { grid = -1; return; }
        if (hipFuncSetAttribute((const void*)hybrid_fwd, hipFuncAttributeMaxDynamicSharedMemorySize, LDS_BYTES) != hipSuccess) { fprintf(stderr, "kernel_launch: hipFuncSetAttribute failed\n"); grid = -1; return; }
        if (hipOccupancyMaxActiveBlocksPerMultiprocessor(&per_cu, (const void*)hybrid_fwd, NWAVES * 64, LDS_BYTES) != hipSuccess || per_cu < 1) { fprintf(stderr, "kernel_launch: occupancy query reports %d workgroups per CU\n", per_cu); }
        (void)hipGetLastError();
        grid = cus;
    }
    if (grid < 0) return;
    if (hipMemsetAsync((char*)d_ws + WS_CTL, 0, CTL_ZERO_BYTES, stream) != hipSuccess) return;
    Args a{};
    for (int i = 0; i < 19; ++i) a.in[i] = (const float*)d_in[i];
    a.out = (float*)d_out; a.ws = (unsigned char*)d_ws;
    hipLaunchKernelGGL(hybrid_fwd, dim3(grid), dim3(NWAVES * 64), LDS_BYTES, stream, a);
}
```
